# Optimizing an MI355X kernel written in HIP

```python
import jax, jax.numpy as jnp
from jax import lax
import numpy as np

D_MODEL = 1024
BATCH = 2
SEQ = 16384
DEPTH = 4

N_MIXERS = 2
MEM_LEN = 256
HEAD_DIM = 64
MEM_HEADS = 4
MEM_WIDTH = MEM_HEADS * HEAD_DIM
TOK_WIDTH = D_MODEL - MEM_WIDTH
MOBA_HEADS = TOK_WIDTH // HEAD_DIM
MOBA_BLOCK = 256
MOBA_TOPK = 3
Q_CHUNK = 128
POOL_WINDOWS = (2, 4, 8, 16)
POOL_GROUPS = len(POOL_WINDOWS)
POOL_GROUP_WIDTH = TOK_WIDTH // POOL_GROUPS
D_FF = 4 * D_MODEL
ROPE_THETA = 10000.0
EPS = 1e-6
NEG = -1e30
N_POOL_LAYERS = (DEPTH + 1) // 2
N_MOBA_LAYERS = DEPTH // 2

kernel_name = "hybrid_pool_moba_memxattn_trunk"


def rms_norm(x, g):
    xf = x.astype(jnp.float32)
    y = xf * lax.rsqrt(jnp.mean(xf * xf, axis=-1, keepdims=True) + EPS)
    return (y * g.astype(jnp.float32)).astype(x.dtype)


def rope_tables(seq_len):
    pos = jnp.arange(seq_len, dtype=jnp.float32)
    inv = ROPE_THETA ** (-jnp.arange(0, HEAD_DIM, 2, dtype=jnp.float32) / HEAD_DIM)
    ang = pos[:, None] * inv[None, :]
    return jnp.cos(ang), jnp.sin(ang)


def apply_rope(x, cos, sin):
    x1, x2 = jnp.split(x, 2, axis=-1)
    c = cos.astype(x.dtype)
    s = sin.astype(x.dtype)
    return jnp.concatenate([x1 * c - x2 * s, x2 * c + x1 * s], axis=-1)


def causal_window_mean(u, w):
    S = u.shape[1]
    c = jnp.cumsum(u.astype(jnp.float32), axis=1)
    c = jnp.pad(c, ((0, 0), (1, 0), (0, 0)))
    hi = c[:, 1:]
    lo = jnp.pad(c[:, :S + 1 - w], ((0, 0), (w - 1, 0), (0, 0)))
    cnt = jnp.minimum(jnp.arange(S) + 1, w).astype(jnp.float32)[None, :, None]
    return (hi - lo) / cnt


def pool_mixer(u, w_group, scale):
    B, S, _ = u.shape
    ug = u.reshape(B, S, POOL_GROUPS, POOL_GROUP_WIDTH)
    pooled = jnp.stack([causal_window_mean(ug[:, :, g], w) for g, w in enumerate(POOL_WINDOWS)], axis=2)
    d = (pooled - ug.astype(jnp.float32)).astype(u.dtype)
    y = jnp.einsum('bsgc,gcd->bsgd', d, w_group)
    return y.reshape(B, S, TOK_WIDTH) * scale


def moba_mixer(qkv, q_gain, k_gain, cos, sin):
    B, S, _ = qkv.shape
    q, k, v = jnp.split(qkv, 3, axis=-1)

    def heads(t):
        return t.reshape(B, S, MOBA_HEADS, HEAD_DIM).transpose(0, 2, 1, 3)

    q = apply_rope(rms_norm(heads(q), q_gain), cos, sin)
    k = apply_rope(rms_norm(heads(k), k_gain), cos, sin)
    v = heads(v)
    H = MOBA_HEADS
    nb = -(-S // MOBA_BLOCK)
    pad = nb * MOBA_BLOCK - S
    kb = jnp.pad(k, ((0, 0), (0, 0), (0, pad), (0, 0))).reshape(B, H, nb, MOBA_BLOCK, HEAD_DIM)
    vb = jnp.pad(v, ((0, 0), (0, 0), (0, pad), (0, 0))).reshape(B, H, nb, MOBA_BLOCK, HEAD_DIM)
    k_mean = jnp.mean(kb.astype(jnp.float32), axis=3)
    topk = min(MOBA_TOPK, nb)
    n_chunks = S // Q_CHUNK
    scale = HEAD_DIM ** -0.5
    bi = jnp.arange(B)[:, None, None, None]
    hi = jnp.arange(H)[None, :, None, None]
    block_ids = jnp.arange(nb)
    key_off = jnp.arange(MOBA_BLOCK)
    q_off = jnp.arange(Q_CHUNK)

    def chunk(ci):
        q0 = ci * Q_CHUNK
        own = q0 // MOBA_BLOCK
        qc = lax.dynamic_slice_in_dim(q, q0, Q_CHUNK, axis=2)
        g = jnp.einsum('bhcd,bhnd->bhcn', qc.astype(jnp.float32), k_mean)
        g = jnp.where(block_ids < own, g, -jnp.inf)
        _, idx = lax.top_k(g, topk)
        valid = idx < own
        k_sel = kb[bi, hi, idx]
        v_sel = vb[bi, hi, idx]
        s_sel = jnp.einsum('bhcd,bhcjkd->bhcjk', qc, k_sel).astype(jnp.float32) * scale
        s_sel = jnp.where(valid[..., None], s_sel, NEG)
        k_own = lax.dynamic_index_in_dim(kb, own, axis=2, keepdims=False)
        v_own = lax.dynamic_index_in_dim(vb, own, axis=2, keepdims=False)
        s_own = jnp.einsum('bhcd,bhkd->bhck', qc, k_own).astype(jnp.float32) * scale
        qpos = q0 + q_off
        kpos = own * MOBA_BLOCK + key_off
        s_own = jnp.where(kpos[None, :] <= qpos[:, None], s_own, NEG)
        s = jnp.concatenate([s_sel.reshape(B, H, Q_CHUNK, topk * MOBA_BLOCK), s_own], axis=-1)
        p = jax.nn.softmax(s, axis=-1).astype(v.dtype)
        p_sel = p[..., :topk * MOBA_BLOCK].reshape(B, H, Q_CHUNK, topk, MOBA_BLOCK)
        p_own = p[..., topk * MOBA_BLOCK:]
        return (jnp.einsum('bhcjk,bhcjkd->bhcd', p_sel, v_sel)
                + jnp.einsum('bhck,bhkd->bhcd', p_own, v_own))

    out = lax.map(chunk, jnp.arange(n_chunks))
    out = jnp.transpose(out, (1, 2, 0, 3, 4)).reshape(B, H, S, HEAD_DIM)
    return out.transpose(0, 2, 1, 3).reshape(B, S, TOK_WIDTH)


def mem_cross_attention(qm, mem_n, w_mem_kv, q_gain, k_gain):
    B, S, _ = qm.shape
    M = mem_n.shape[1]
    k, v = jnp.split(mem_n @ w_mem_kv, 2, axis=-1)
    q = rms_norm(qm.reshape(B, S, MEM_HEADS, HEAD_DIM), q_gain)
    k = rms_norm(k.reshape(B, M, MEM_HEADS, HEAD_DIM), k_gain)
    v = v.reshape(B, M, MEM_HEADS, HEAD_DIM)
    s = jnp.einsum('bshd,bmhd->bhsm', q, k).astype(jnp.float32) * (HEAD_DIM ** -0.5)
    p = jax.nn.softmax(s, axis=-1).astype(v.dtype)
    o = jnp.einsum('bhsm,bmhd->bshd', p, v)
    return o.reshape(B, S, MEM_WIDTH)


def setup_inputs(seed: int = 0) -> dict:
    key = jax.random.key(seed)
    ks = jax.random.split(key, 20)
    f32 = jnp.float32

    def w(k, shape, fan_in):
        return jax.random.normal(k, shape, f32) * (fan_in ** -0.5)

    def gain(k, shape):
        return 1.0 + 0.1 * jax.random.normal(k, shape, f32)

    return {
        "x": jax.random.normal(ks[0], (BATCH, SEQ, D_MODEL), f32),
        "mem": jax.random.normal(ks[1], (BATCH, MEM_LEN, D_MODEL), f32),
        "g_mix": gain(ks[2], (DEPTH, D_MODEL)),
        "g_mem": gain(ks[3], (DEPTH, D_MODEL)),
        "g_mlp": gain(ks[4], (DEPTH, D_MODEL)),
        "w_in_pool": w(ks[5], (N_POOL_LAYERS, D_MODEL, TOK_WIDTH + MEM_WIDTH), D_MODEL),
        "w_pool_group": w(ks[6], (N_POOL_LAYERS, POOL_GROUPS, POOL_GROUP_WIDTH, POOL_GROUP_WIDTH), POOL_GROUP_WIDTH),
        "pool_scale": gain(ks[7], (N_POOL_LAYERS, TOK_WIDTH)),
        "w_in_moba": w(ks[8], (N_MOBA_LAYERS, D_MODEL, 3 * TOK_WIDTH + MEM_WIDTH), D_MODEL),
        "moba_q_gain": gain(ks[9], (N_MOBA_LAYERS, HEAD_DIM)),
        "moba_k_gain": gain(ks[10], (N_MOBA_LAYERS, HEAD_DIM)),
        "w_mem_kv": w(ks[11], (DEPTH, D_MODEL, 2 * MEM_WIDTH), D_MODEL),
        "mem_q_gain": gain(ks[12], (DEPTH, HEAD_DIM)),
        "mem_k_gain": gain(ks[13], (DEPTH, HEAD_DIM)),
        "w_out": w(ks[14], (DEPTH, TOK_WIDTH + MEM_WIDTH, D_MODEL), TOK_WIDTH + MEM_WIDTH),
        "w_ff1": w(ks[15], (DEPTH, D_MODEL, D_FF), D_MODEL),
        "w_ff2": w(ks[16], (DEPTH, D_FF, D_MODEL), D_FF),
    }


def reference(x, mem, g_mix, g_mem, g_mlp, w_in_pool, w_pool_group, pool_scale,
              w_in_moba, moba_q_gain, moba_k_gain, w_mem_kv, mem_q_gain, mem_k_gain,
              w_out, w_ff1, w_ff2):
    S = x.shape[1]
    cos, sin = rope_tables(S)
    for i in range(DEPTH):
        j = i // N_MIXERS
        u = rms_norm(x, g_mix[i])
        mem_n = rms_norm(mem, g_mem[i])
        if i % N_MIXERS == 0:
            h = u @ w_in_pool[j]
            tok = pool_mixer(h[..., :TOK_WIDTH], w_pool_group[j], pool_scale[j])
            qm = h[..., TOK_WIDTH:]
        else:
            h = u @ w_in_moba[j]
            tok = moba_mixer(h[..., :3 * TOK_WIDTH], moba_q_gain[j], moba_k_gain[j], cos, sin)
            qm = h[..., 3 * TOK_WIDTH:]
        mo = mem_cross_attention(qm, mem_n, w_mem_kv[i], mem_q_gain[i], mem_k_gain[i])
        x = x + jnp.concatenate([tok, mo], axis=-1) @ w_out[i]
        u = rms_norm(x, g_mlp[i])
        x = x + jnp.square(jax.nn.relu(u @ w_ff1[i])) @ w_ff2[i]
    return x
```

```cpp
#include <hip/hip_runtime.h>
#include <hip/hip_cooperative_groups.h>
#include <cstdio>
#include <cstdint>
namespace cg = cooperative_groups;
#ifndef MK_SINGLE
#define MK_SINGLE 1
#endif
namespace pg8 {
#define PG8_LAS __attribute__((address_space(3)))
typedef unsigned short bf16_t;
typedef short bf16x8 __attribute__((ext_vector_type(8)));
typedef float f32x4 __attribute__((ext_vector_type(4)));
typedef unsigned u32x4 __attribute__((ext_vector_type(4)));
constexpr int BM = 256, BK = 64, HALF = 128, HTB = HALF * BK * 2  , STAGE_BYTES = 8 * HTB, NXCD = 8, WGM = 4;

__host__ __device__ __forceinline__ int lds_byte(int r, int c) { const int st = (r >> 4) * 2 + (c >> 5), rr = r & 15, cc = c & 31, ob = rr * 64 + cc * 2; return st * 1024 + (ob ^ (((ob >> 9) & 1) << 5)); }
__host__ __device__ __forceinline__ void stage_rc(int b, int& R, int& C) { const int st = b / 1024, sb = b % 1024, swz = sb ^ (((sb >> 9) & 1) << 5); R = (st >> 1) * 16 + swz / 64; C = (st & 1) * 32 + (swz % 64) / 2; }
__host__ __device__ __forceinline__ int perm32(int rho) { const int n = rho >> 4, i = rho & 15; return 8 * (i >> 2) + 4 * n + (i & 3); }

struct Unit { int pm, pn; };
struct Gemm { const bf16_t* A; const bf16_t* Bt; int M, N, K; };

struct StaticOrder {
    int nM, nN, nwg, G, c;
    __host__ __device__ void init(int M, int N, int G_, int c_) { nM = M / BM; nN = N / BM; nwg = nM * nN; G = G_; c = c_; }
    __host__ __device__ bool next(int i, Unit& u) const {
        const long L = (long)i * G + c; if (L >= nwg) return false;
        int wgid = (int)L; { const int q = nwg / NXCD, r = nwg % NXCD, xcd = wgid % NXCD, off = wgid / NXCD; wgid = (xcd < r ? xcd * (q + 1) : r * (q + 1) + (xcd - r) * q) + off; }
        const int nig = WGM * nN, gid = wgid / nig, fm = gid * WGM, gsz = (nM - fm) < WGM ? (nM - fm) : WGM;
        u.pm = fm + ((wgid % nig) % gsz); u.pn = (wgid % nig) / gsz; return true;
    }
    __device__ __forceinline__ void a_ready(const Unit&) const {}
    __device__ __forceinline__ void done(const Unit&) const {}
};

__device__ __forceinline__ unsigned cvt_pk_bf16(float lo, float hi) { unsigned r; asm volatile("v_cvt_pk_bf16_f32 %0, %1, %2" : "=v"(r) : "v"(lo), "v"(hi)); return r; }

template <int ACT> struct EpiScale {
    static constexpr bool PERM = true, AFTER_DRAIN = false;
    bf16_t* O; int ldc; const float* ss;
    __device__ __forceinline__ void operator()(const f32x4 (&acc)[2][2][4][2], const Unit& u, int wr, int wc, int fr, int fq) const {
        const int row0 = u.pm * BM + wr * 64 + fr, col0 = u.pn * BM + wc * 32 + 8 * fq;
#pragma unroll
        for (int ai = 0; ai < 2; ++ai)
#pragma unroll
            for (int m = 0; m < 4; ++m) {
                const int row = row0 + ai * HALF + m * 16;
                const f32x4* sp = (const f32x4*)(ss + (size_t)row * 16);
                const f32x4 a0 = sp[0], a1 = sp[1], a2 = sp[2], a3 = sp[3];
                const float tot = ((a0.x + a0.y) + (a0.z + a0.w)) + ((a1.x + a1.y) + (a1.z + a1.w)) + ((a2.x + a2.y) + (a2.z + a2.w)) + ((a3.x + a3.y) + (a3.z + a3.w));
                const float rs = rsqrtf(tot * (1.0f / 1024.0f) + 1e-6f);
                bf16_t* rowp = O + (size_t)row * ldc + col0;
#pragma unroll
                for (int bj = 0; bj < 2; ++bj) {
                    f32x4 v0 = acc[ai][bj][m][0] * rs, v1 = acc[ai][bj][m][1] * rs;
                    if (ACT == 1) {
#pragma unroll
                        for (int e = 0; e < 4; ++e) { float a = fmaxf(v0[e], 0.f); v0[e] = a * a; float b = fmaxf(v1[e], 0.f); v1[e] = b * b; }
                    }
                    u32x4 w; w.x = cvt_pk_bf16(v0[0], v0[1]); w.y = cvt_pk_bf16(v0[2], v0[3]); w.z = cvt_pk_bf16(v1[0], v1[1]); w.w = cvt_pk_bf16(v1[2], v1[3]);
                    *(u32x4*)(rowp + bj * HALF) = w;
                }
            }
    }
};
struct EpiResid {
    static constexpr bool PERM = true, AFTER_DRAIN = false;
    float* xout; bf16_t* xb; float* ss;
    __device__ __forceinline__ void operator()(const f32x4 (&acc)[2][2][4][2], const Unit& u, int wr, int wc, int fr, int fq) const {
        const unsigned row0 = u.pm * BM + wr * 64 + fr, col0 = u.pn * BM + wc * 32 + 8 * fq;
        char* xo = (char*)xout; char* xbp = (char*)xb; char* ssp = (char*)ss;
        const unsigned ssoff = (unsigned)(u.pn * 4 + wc) * 4u;
#pragma unroll
        for (int ai = 0; ai < 2; ++ai)
#pragma unroll
            for (int m = 0; m < 4; ++m) {
                const unsigned row = row0 + ai * HALF + m * 16;
                const unsigned hoff = (row * 1024u + col0) * 2u;
                float sq = 0.f;
#pragma unroll
                for (int bj = 0; bj < 2; ++bj) {
                    const u32x4 xw = *(const u32x4*)(xbp + hoff + bj * (HALF * 2));
                    f32x4 v0, v1;
                    v0[0] = __uint_as_float(xw.x << 16) + acc[ai][bj][m][0][0]; v0[1] = __uint_as_float(xw.x & 0xffff0000u) + acc[ai][bj][m][0][1];
                    v0[2] = __uint_as_float(xw.y << 16) + acc[ai][bj][m][0][2]; v0[3] = __uint_as_float(xw.y & 0xffff0000u) + acc[ai][bj][m][0][3];
                    v1[0] = __uint_as_float(xw.z << 16) + acc[ai][bj][m][1][0]; v1[1] = __uint_as_float(xw.z & 0xffff0000u) + acc[ai][bj][m][1][1];
                    v1[2] = __uint_as_float(xw.w << 16) + acc[ai][bj][m][1][2]; v1[3] = __uint_as_float(xw.w & 0xffff0000u) + acc[ai][bj][m][1][3];
                    if (xout) { *(f32x4*)(xo + 2u * hoff + bj * (HALF * 4)) = v0; *(f32x4*)(xo + 2u * hoff + bj * (HALF * 4) + 16) = v1; }
                    u32x4 w; w.x = cvt_pk_bf16(v0[0], v0[1]); w.y = cvt_pk_bf16(v0[2], v0[3]); w.z = cvt_pk_bf16(v1[0], v1[1]); w.w = cvt_pk_bf16(v1[2], v1[3]);
                    *(u32x4*)(xbp + hoff + bj * (HALF * 2)) = w;
                    sq += (v0[0] * v0[0] + v0[1] * v0[1]) + (v0[2] * v0[2] + v0[3] * v0[3]) + (v1[0] * v1[0] + v1[1] * v1[1]) + (v1[2] * v1[2] + v1[3] * v1[3]);
                }
                sq += __shfl_xor(sq, 16); sq += __shfl_xor(sq, 32);
                if (fq == 0) *(float*)(ssp + row * 64u + ssoff) = sq;
            }
    }
};

template <class Epi, class Sched, bool ALIGN_EPI = false, bool SP2 = false>
__device__ __forceinline__ void gemm_phase(PG8_LAS unsigned char* lds, const Gemm g, const Sched& S, const Epi& E) {
    int tid_l = threadIdx.x; asm volatile("" : "+v"(tid_l));
    const int tid = tid_l, wid = __builtin_amdgcn_readfirstlane(tid >> 6), lane = tid & 63, wr = wid >> 2, wc = wid & 3, fr = lane & 15, fq = lane >> 4;
    const int K = g.K, nt = K / BK;
    unsigned voffA[2], voffB[2];
#pragma unroll
    for (int i = 0; i < 2; ++i) { int R, C; stage_rc(tid * 16 + i * 8192, R, C); const int Rb = Epi::PERM ? ((R & ~31) + perm32(R & 31)) : R;
        voffA[i] = (unsigned)(R * K + C) * 2u; voffB[i] = (unsigned)(Rb * K + C) * 2u; }
    const size_t kstep = (size_t)(BK * 2);
    const size_t hstep = (size_t)HALF * K * 2;
    const size_t tstep = 2 * hstep;
    const unsigned ldsw = (unsigned)wid * 1024u;
    const int aoff = lds_byte(wr * 64 + fr, fq * 8), boff = lds_byte(wc * 32 + fr, fq * 8);
#define PG8_SA(b, h) (((b) * 2 + (h)) * HTB)
#define PG8_SB(b, h) ((4 + (b) * 2 + (h)) * HTB)
#define PG8_STAGE(bufoff, gbase, voff) do { _Pragma("unroll") for (int _i = 0; _i < 2; ++_i) \
        __builtin_amdgcn_global_load_lds((const unsigned*)((const char*)(gbase) + (voff)[_i]), (PG8_LAS unsigned*)(lds + (bufoff) + ldsw + _i * 8192), 16, 0, 0); } while (0)
#define PG8_LDA(dst, b, h) do { _Pragma("unroll") for (int m = 0; m < 4; ++m) _Pragma("unroll") for (int k = 0; k < 2; ++k) dst[m][k] = *(const PG8_LAS bf16x8*)(lds + PG8_SA(b, h) + aoff + m * 2048 + k * 1024); } while (0)
#define PG8_LDB(dst, b, h) do { _Pragma("unroll") for (int n = 0; n < 2; ++n) _Pragma("unroll") for (int k = 0; k < 2; ++k) dst[n][k] = *(const PG8_LAS bf16x8*)(lds + PG8_SB(b, h) + boff + n * 2048 + k * 1024); } while (0)
#define PG8_MMA(ai, bj, At, Bt) do { __builtin_amdgcn_s_setprio(1); _Pragma("unroll") for (int m = 0; m < 4; ++m) _Pragma("unroll") for (int n = 0; n < 2; ++n) _Pragma("unroll") for (int k = 0; k < 2; ++k) \
        acc[ai][bj][m][n] = __builtin_amdgcn_mfma_f32_16x16x32_bf16(Bt[n][k], At[m][k], acc[ai][bj][m][n], 0, 0, 0); __builtin_amdgcn_s_setprio(0); } while (0)
#define PG8_WAIT_V(n) asm volatile("s_waitcnt vmcnt(" #n ")" ::: "memory")
#define PG8_WAIT_L(n) asm volatile("s_waitcnt lgkmcnt(" #n ")" ::: "memory")
#define PG8_BAR __builtin_amdgcn_s_barrier()
#define PG8_SCHED __builtin_amdgcn_sched_barrier(0)
    Unit cur, nxt; int ui = 0;
    if (!S.next(0, cur)) return;
    f32x4 acc[2][2][4][2];
#pragma unroll
    for (int a = 0; a < 2; ++a)
#pragma unroll
        for (int b = 0; b < 2; ++b)
#pragma unroll
            for (int m = 0; m < 4; ++m)
#pragma unroll
                for (int n = 0; n < 2; ++n) acc[a][b][m][n] = (f32x4){0.f, 0.f, 0.f, 0.f};
    bf16x8 At[4][2], B0[2][2], B1[2][2];
    const char* cA = (const char*)g.A + (size_t)cur.pm * tstep; const char* cB = (const char*)g.Bt + (size_t)cur.pn * tstep;
    S.a_ready(cur);
    if constexpr (SP2) {
        PG8_STAGE(PG8_SB(0, 0), cB, voffB); PG8_STAGE(PG8_SB(0, 1), cB + hstep, voffB); PG8_STAGE(PG8_SA(0, 0), cA, voffA); PG8_STAGE(PG8_SA(0, 1), cA + hstep, voffA);
        if (wr == 1) PG8_BAR;
        PG8_WAIT_V(2); PG8_BAR;
        PG8_STAGE(PG8_SB(1, 0), cB + kstep, voffB); PG8_STAGE(PG8_SA(1, 0), cA + kstep, voffA); PG8_STAGE(PG8_SB(1, 1), cB + hstep + kstep, voffB);
        PG8_WAIT_V(6); PG8_BAR;
    } else {
        PG8_STAGE(PG8_SB(0, 0), cB, voffB); PG8_STAGE(PG8_SA(0, 0), cA, voffA); PG8_STAGE(PG8_SB(0, 1), cB + hstep, voffB); PG8_STAGE(PG8_SA(0, 1), cA + hstep, voffA);
        if (wr == 1) PG8_BAR;
        PG8_WAIT_V(4); PG8_BAR;
        PG8_STAGE(PG8_SB(1, 0), cB + kstep, voffB); PG8_STAGE(PG8_SA(1, 0), cA + kstep, voffA); PG8_STAGE(PG8_SB(1, 1), cB + hstep + kstep, voffB);
        PG8_WAIT_V(6); PG8_BAR;
    }
    for (;;) {
        const bool has_next = S.next(ui + 1, nxt);
        const char* nA = has_next ? (const char*)g.A + (size_t)nxt.pm * tstep : cA; const char* nB = has_next ? (const char*)g.Bt + (size_t)nxt.pn * tstep : cB;
        for (int t = 0; t < nt; t += 2) {
            const bool last = (t == nt - 2);
            const char* a1 = cA + (size_t)(t + 1) * kstep;
            const char* a2 = last ? nA : cA + (size_t)(t + 2) * kstep; const char* b2 = last ? nB : cB + (size_t)(t + 2) * kstep;
            const char* a3 = a2 + kstep; const char* b3 = b2 + kstep;
            if (last && has_next) S.a_ready(nxt);
            if constexpr (SP2) {
            PG8_LDB(B0, 0, 0); PG8_LDB(B1, 0, 1); PG8_SCHED; PG8_LDA(At, 0, 0); PG8_STAGE(PG8_SA(1, 1), a1 + hstep, voffA);
            PG8_WAIT_V(8); PG8_WAIT_L(0); PG8_BAR; PG8_MMA(0, 0, At, B0); PG8_MMA(0, 1, At, B1); PG8_BAR; PG8_SCHED;
            PG8_LDA(At, 0, 1); PG8_STAGE(PG8_SB(0, 0), b2, voffB); PG8_STAGE(PG8_SB(0, 1), b2 + hstep, voffB); PG8_STAGE(PG8_SA(0, 0), a2, voffA);
            PG8_WAIT_V(8); PG8_WAIT_L(0); PG8_BAR; PG8_MMA(1, 0, At, B0); PG8_MMA(1, 1, At, B1); PG8_BAR; PG8_SCHED;
            PG8_LDB(B0, 1, 0); PG8_LDB(B1, 1, 1); PG8_SCHED; PG8_LDA(At, 1, 0); PG8_STAGE(PG8_SA(0, 1), a2 + hstep, voffA);
            PG8_WAIT_V(8); PG8_WAIT_L(0); PG8_BAR; PG8_MMA(0, 0, At, B0); PG8_MMA(0, 1, At, B1); PG8_BAR; PG8_SCHED;
            PG8_LDA(At, 1, 1); PG8_STAGE(PG8_SB(1, 0), b3, voffB); PG8_STAGE(PG8_SB(1, 1), b3 + hstep, voffB); PG8_STAGE(PG8_SA(1, 0), a3, voffA);
            PG8_WAIT_V(8); PG8_WAIT_L(0); PG8_BAR; PG8_MMA(1, 0, At, B0); PG8_MMA(1, 1, At, B1); PG8_BAR; PG8_SCHED;
            } else {
            PG8_LDB(B0, 0, 0); PG8_SCHED; PG8_LDA(At, 0, 0); PG8_STAGE(PG8_SA(1, 1), a1 + hstep, voffA);
            PG8_WAIT_L(8); PG8_BAR; PG8_WAIT_L(0); PG8_MMA(0, 0, At, B0); PG8_BAR; PG8_SCHED;
            PG8_LDB(B1, 0, 1); PG8_STAGE(PG8_SB(0, 0), b2, voffB);
            PG8_BAR; PG8_WAIT_L(0); PG8_MMA(0, 1, At, B1); PG8_BAR;
            PG8_LDA(At, 0, 1); PG8_STAGE(PG8_SA(0, 0), a2, voffA);
            PG8_BAR; PG8_WAIT_L(0); PG8_MMA(1, 0, At, B0); PG8_BAR; PG8_SCHED;
            PG8_STAGE(PG8_SB(0, 1), b2 + hstep, voffB);
            PG8_WAIT_V(6); PG8_BAR; PG8_MMA(1, 1, At, B1); PG8_BAR;
            PG8_LDB(B0, 1, 0); PG8_SCHED; PG8_LDA(At, 1, 0); PG8_STAGE(PG8_SA(0, 1), a2 + hstep, voffA);
            PG8_WAIT_L(8); PG8_BAR; PG8_WAIT_L(0); PG8_MMA(0, 0, At, B0); PG8_BAR; PG8_SCHED;
            PG8_LDB(B1, 1, 1); PG8_STAGE(PG8_SB(1, 0), b3, voffB);
            PG8_BAR; PG8_WAIT_L(0); PG8_MMA(0, 1, At, B1); PG8_BAR;
            PG8_LDA(At, 1, 1); PG8_STAGE(PG8_SA(1, 0), a3, voffA);
            PG8_BAR; PG8_WAIT_L(0); PG8_MMA(1, 0, At, B0); PG8_BAR; PG8_SCHED;
            PG8_STAGE(PG8_SB(1, 1), b3 + hstep, voffB);
            PG8_WAIT_V(6); PG8_BAR; PG8_MMA(1, 1, At, B1); PG8_BAR;
            }
        }
        if constexpr (ALIGN_EPI) { if (wr == 0) PG8_BAR; }
        if constexpr (!Epi::AFTER_DRAIN) { E(acc, cur, wr, wc, fr, fq); S.done(cur); }
        if (!has_next) break;
#pragma unroll
        for (int a = 0; a < 2; ++a)
#pragma unroll
            for (int b = 0; b < 2; ++b)
#pragma unroll
                for (int m = 0; m < 4; ++m)
#pragma unroll
                    for (int n = 0; n < 2; ++n) acc[a][b][m][n] = (f32x4){0.f, 0.f, 0.f, 0.f};
        cur = nxt; cA = nA; cB = nB; ++ui;
        if constexpr (ALIGN_EPI) { if (wr == 1) PG8_BAR; }
    }
    PG8_WAIT_V(0);
    if constexpr (!ALIGN_EPI) { if (wr == 0) PG8_BAR; }
    PG8_BAR;
    if constexpr (Epi::AFTER_DRAIN) { E.fused(acc, cur, wr, wc, fr, fq, lds, wid, lane); S.done(cur); }
#undef PG8_SA
#undef PG8_SB
#undef PG8_STAGE
#undef PG8_LDA
#undef PG8_LDB
#undef PG8_MMA
#undef PG8_WAIT_V
#undef PG8_WAIT_L
#undef PG8_BAR
#undef PG8_SCHED
}
}
#define XB_TMO      128
#define XB_XCNT(j)  (256  + 64 * (j))
#define XB_XSUB(j)  (1280 + 64 * (j))
#define XB_XGEN(j)  (2304 + 64 * (j))
#define XB_TOP      3328
#define XB_TOPGEN   3392
#define XCD_BAR_WORDS 3456
#define XB_SPIN_CAP (1u << 18)
#define LAS __attribute__((address_space(3)))

__device__ __forceinline__ unsigned xb_ld(unsigned* p)              { return __hip_atomic_load(p, __ATOMIC_RELAXED, __HIP_MEMORY_SCOPE_AGENT); }
__device__ __forceinline__ unsigned xb_add(unsigned* p, unsigned v) { return __hip_atomic_fetch_add(p, v, __ATOMIC_RELAXED, __HIP_MEMORY_SCOPE_AGENT); }
__device__ __forceinline__ unsigned xb_xcc_id() { return (unsigned)__builtin_amdgcn_s_getreg((3 << 11) | 20) & 0xFu; }
#define XB_SPIN(cond, bar) do { unsigned _sp = 0; while (cond) { __builtin_amdgcn_s_sleep(1); \
    if ((++_sp & 255u) == 0u) { if (xb_ld(&(bar)[XB_TMO])) break; if (_sp > XB_SPIN_CAP) { atomicAdd(&(bar)[XB_TMO], 1u); break; } } } } while (0)

struct XcdBarrier {
    unsigned* bar; unsigned x;
    volatile LAS unsigned* st;
};

__device__ __forceinline__ XcdBarrier xcd_barrier_post(unsigned* bar, volatile LAS unsigned* st) {
    XcdBarrier b; b.bar = bar; b.x = xb_xcc_id(); b.st = st;
    if (threadIdx.x == 0) (void)xb_add(&bar[XB_XCNT(b.x)], 1u);
    return b;
}
__device__ __forceinline__ void xcd_barrier_complete(unsigned* bar, unsigned x, unsigned& nloc, unsigned& nx) {
    const unsigned G = gridDim.x * gridDim.y * gridDim.z;
    unsigned sum, cnt, mine, sp = 0u;
    for (;;) {
        sum = 0u; cnt = 0u; mine = 0u;
#pragma unroll
        for (unsigned j = 0; j < 16; ++j) { const unsigned c = xb_ld(&bar[XB_XCNT(j)]); sum += c; cnt += (c > 0u) ? 1u : 0u; mine = (j == x) ? c : mine; }
        if (sum == G) break;
        __builtin_amdgcn_s_sleep(1);
        if ((++sp & 255u) == 0u) { if (xb_ld(&bar[XB_TMO])) break; if (sp > XB_SPIN_CAP) { atomicAdd(&bar[XB_TMO], 1u); break; } }
    }
    nloc = mine > 0u ? mine : 1u; nx = cnt > 0u ? cnt : 1u;
}

__device__ __forceinline__ void xcd_barrier(const XcdBarrier& b) {
    asm volatile("s_waitcnt vmcnt(0)" ::: "memory");
    __syncthreads();
    if (threadIdx.x == 0) {
        unsigned* bar = b.bar;
        __builtin_amdgcn_s_waitcnt(0);
        unsigned nloc = b.st[0], nx = b.st[1];
        if (nloc == 0u) { xcd_barrier_complete(bar, b.x, nloc, nx); b.st[0] = nloc; b.st[1] = nx; }
        const unsigned old = xb_add(&bar[XB_XSUB(b.x)], 1u);
        const unsigned gen = old / nloc;
        if (old + 1u == (gen + 1u) * nloc) {
            __builtin_amdgcn_fence(__ATOMIC_RELEASE, "agent");
            asm volatile("s_waitcnt vmcnt(0)" ::: "memory");
            const unsigned og = xb_add(&bar[XB_TOP], 1u);
            const unsigned tg = og / nx;
            if (og + 1u == (tg + 1u) * nx) xb_add(&bar[XB_TOPGEN], 1u);
            else XB_SPIN(xb_ld(&bar[XB_TOPGEN]) == tg, bar);
            __builtin_amdgcn_fence(__ATOMIC_ACQUIRE, "agent");
            xb_add(&bar[XB_XGEN(b.x)], 1u);
            asm volatile("s_waitcnt vmcnt(0)" ::: "memory");
        } else {
            XB_SPIN(xb_ld(&bar[XB_XGEN(b.x)]) == gen, bar);
            __builtin_amdgcn_fence(__ATOMIC_ACQUIRE, "agent");
            asm volatile("s_waitcnt vmcnt(0)" ::: "memory");
        }
    }
    __syncthreads();
}


using pg8::bf16_t; using pg8::bf16x8; using pg8::f32x4; using pg8::u32x4; using pg8::cvt_pk_bf16;
typedef unsigned u32x2 __attribute__((ext_vector_type(2)));
constexpr int D = 1024, SEQ = 16384, NB = 2, M = NB * SEQ, DEPTH = 4, NH = 12, HD = 64, DFF = 4096, NMOBA = 2560;
constexpr int LDS_BYTES = 147456;
constexpr float QSCALE = 0.125f * 1.4426950408889634f;
constexpr int LIST_PER_BH = 256 * 2016;
constexpr size_t MB1 = 1048576;
constexpr size_t WT_ELEMS = 2 * (size_t)D * D + 2 * (size_t)NMOBA * D + 4 * (size_t)D * D + 4 * (size_t)DFF * D + 4 * (size_t)D * DFF + (size_t)2048 * D;
constexpr size_t OFF_WT = 0;
constexpr size_t OFF_XB = OFF_WT + WT_ELEMS * 2;
constexpr size_t OFF_SS = OFF_XB + (size_t)M * D * 2;
constexpr size_t OFF_MEMB = OFF_SS + (size_t)M * 16 * 4;
constexpr size_t OFF_SSM = OFF_MEMB + (size_t)512 * D * 2;
constexpr size_t OFF_MEMKV = OFF_SSM + (size_t)512 * 16 * 4;
constexpr size_t OFF_ROPE = OFF_MEMKV + (size_t)512 * 2048 * 2;
constexpr size_t OFF_KMEAN = OFF_ROPE + (size_t)2 * SEQ * 32 * 4;
constexpr size_t OFF_CNT = OFF_KMEAN + (size_t)1536 * 64 * 4;
constexpr size_t OFF_BAR = OFF_CNT + 4 * 1536 * 4 + 4096;
constexpr size_t OFF_BIG = OFF_BAR + 16384;
static_assert(XCD_BAR_WORDS * 4 <= 16384, "barrier words");
constexpr size_t OFF_H = OFF_BIG;
constexpr size_t OFF_AO = OFF_H + (size_t)M * NMOBA * 2;
constexpr size_t OFF_KIMG = OFF_AO + (size_t)M * D * 2;
constexpr size_t OFF_VT = OFF_KIMG + (size_t)1536 * 16384 * 2;
constexpr size_t OFF_LIST = OFF_VT + (size_t)1536 * 16384 * 2;
constexpr size_t WS_END = OFF_LIST + (size_t)24 * LIST_PER_BH * 2;
constexpr size_t OFF_ACT = OFF_BIG;
static_assert(OFF_ACT + (size_t)M * DFF * 2 <= WS_END, "ACT overlay");
constexpr size_t OFF_OPART = OFF_H;
constexpr size_t OFF_LSE = OFF_OPART + (size_t)SEQ * 12 * 4 * 64 * 2;
static_assert(OFF_LSE + (size_t)SEQ * 12 * 4 * 4 <= OFF_AO, "partials overlay");
static_assert(WS_END <= (size_t)536870912, "workspace budget");
__host__ __device__ constexpr size_t wt_in(int layer) { return (size_t)(layer >> 1) * ((size_t)D * D + (size_t)NMOBA * D) + ((layer & 1) ? (size_t)D * D : 0); }
constexpr size_t WT_OUT = 2 * ((size_t)D * D + (size_t)NMOBA * D), WT_FF1 = WT_OUT + 4 * (size_t)D * D, WT_FF2 = WT_FF1 + 4 * (size_t)DFF * D, WT_MEM = WT_FF2 + 4 * (size_t)D * DFF;

struct Params { const float* in[17]; float* out; unsigned char* ws; int ph_lo, ph_hi; };

__device__ __forceinline__ void unpack8(const u32x4 w, float* f) {
    f[0] = __uint_as_float(w.x << 16); f[1] = __uint_as_float(w.x & 0xffff0000u); f[2] = __uint_as_float(w.y << 16); f[3] = __uint_as_float(w.y & 0xffff0000u);
    f[4] = __uint_as_float(w.z << 16); f[5] = __uint_as_float(w.z & 0xffff0000u); f[6] = __uint_as_float(w.w << 16); f[7] = __uint_as_float(w.w & 0xffff0000u);
}
__device__ __forceinline__ u32x4 pack8(const float* f) { u32x4 w; w.x = cvt_pk_bf16(f[0], f[1]); w.y = cvt_pk_bf16(f[2], f[3]); w.z = cvt_pk_bf16(f[4], f[5]); w.w = cvt_pk_bf16(f[6], f[7]); return w; }
__device__ __forceinline__ float wave_sum(float v) {
#pragma unroll
    for (int o = 1; o < 64; o <<= 1) v += __shfl_xor(v, o);
    return v;
}
#define LDS_FENCE() asm volatile("s_waitcnt lgkmcnt(0)" ::: "memory")
template <int CTRL> __device__ __forceinline__ float dpp_f(float x) { return __int_as_float(__builtin_amdgcn_update_dpp(0, __float_as_int(x), CTRL, 0xF, 0xF, true)); }
#define DPP_XOR1 0xB1
#define DPP_XOR2 0x4E
#define DPP_ROR4 0x124
#define DPP_ROR8 0x128
__device__ __forceinline__ int launder(int v) { asm volatile("" : "+v"(v)); return v; }

__device__ __forceinline__ void transpose_item(const float* __restrict__ W, int ldw, int K, int N, const float* __restrict__ g, bf16_t* __restrict__ WT, float* scr, int item, int lane) {
    const int nblk = N / 32, kb = item / nblk, nb = item - kb * nblk, k0 = 64 * kb, n0 = 32 * nb;
#pragma unroll 8
    for (int i = 0; i < 32; ++i) { const int kk = 2 * i + (lane >> 5); float v = W[(size_t)(k0 + kk) * ldw + n0 + (lane & 31)]; if (g) v *= g[k0 + kk]; scr[kk * 33 + (lane & 31)] = v; }
    LDS_FENCE();
    const int c = lane & 7;
#pragma unroll
    for (int j = 0; j < 4; ++j) { const int n = (lane >> 3) + 8 * j; const float* s = scr + (8 * c) * 33 + n;
        u32x4 o; o.x = cvt_pk_bf16(s[0 * 33], s[1 * 33]); o.y = cvt_pk_bf16(s[2 * 33], s[3 * 33]); o.z = cvt_pk_bf16(s[4 * 33], s[5 * 33]); o.w = cvt_pk_bf16(s[6 * 33], s[7 * 33]);
        *(u32x4*)(WT + (size_t)(n0 + n) * K + k0 + 8 * c) = o; }
    LDS_FENCE();
}
__device__ __forceinline__ void transpose_item2(const float* __restrict__ W, int ldw, int K, int N, const float* __restrict__ g, bf16_t* __restrict__ WT, float* scr, int itemA, int itemB, int lane) {
    const int nblk = N / 32;
    const int kbA = itemA / nblk, nbA = itemA - kbA * nblk, kA = 64 * kbA, nA = 32 * nbA;
    const int kbB = itemB / nblk, nbB = itemB - kbB * nblk, kB = 64 * kbB, nB = 32 * nbB;
    float va[32], vb[32];
#pragma unroll
    for (int i = 0; i < 32; ++i) { const int kk = 2 * i + (lane >> 5); va[i] = W[(size_t)(kA + kk) * ldw + nA + (lane & 31)]; vb[i] = W[(size_t)(kB + kk) * ldw + nB + (lane & 31)]; }
#pragma unroll
    for (int pass = 0; pass < 2; ++pass) {
        const int k0 = pass ? kB : kA, n0 = pass ? nB : nA;
#pragma unroll
        for (int i = 0; i < 32; ++i) { const int kk = 2 * i + (lane >> 5); float v = pass ? vb[i] : va[i]; if (g) v *= g[k0 + kk]; scr[kk * 33 + (lane & 31)] = v; }
        LDS_FENCE();
        const int c = lane & 7;
#pragma unroll
        for (int j = 0; j < 4; ++j) { const int n = (lane >> 3) + 8 * j; const float* s = scr + (8 * c) * 33 + n;
            u32x4 o; o.x = cvt_pk_bf16(s[0 * 33], s[1 * 33]); o.y = cvt_pk_bf16(s[2 * 33], s[3 * 33]); o.z = cvt_pk_bf16(s[4 * 33], s[5 * 33]); o.w = cvt_pk_bf16(s[6 * 33], s[7 * 33]);
            *(u32x4*)(WT + (size_t)(n0 + n) * K + k0 + 8 * c) = o; }
        LDS_FENCE();
    }
}
__device__ __forceinline__ void transpose_job(const float* W, int ldw, int K, int N, const float* g, bf16_t* WT, float* scr, int& base, int gwave, int gwaves, int lane) {
    const int nitems = (K / 64) * (N / 32);
    int start = (gwave - (base % gwaves) + gwaves) % gwaves;
    int it = start;
    for (; it + gwaves < nitems; it += 2 * gwaves) transpose_item2(W, ldw, K, N, g, WT, scr, it, it + gwaves, lane);
    if (it < nitems) transpose_item(W, ldw, K, N, g, WT, scr, it, lane);
    base += nitems;
}
__device__ __forceinline__ void row_to_bf16(const float* xrow, bf16_t* orow, float* ssrow, int lane) {
    const f32x4* xr = (const f32x4*)xrow + lane;
    f32x4 v[4]; float s = 0.f;
#pragma unroll
    for (int j = 0; j < 4; ++j) { v[j] = xr[64 * j]; s += (v[j].x * v[j].x + v[j].y * v[j].y) + (v[j].z * v[j].z + v[j].w * v[j].w); }
    s = wave_sum(s);
    u32x2* o8 = (u32x2*)orow + lane;
#pragma unroll
    for (int j = 0; j < 4; ++j) { u32x2 w; w.x = cvt_pk_bf16(v[j].x, v[j].y); w.y = cvt_pk_bf16(v[j].z, v[j].w); o8[64 * j] = w; }
    if (lane < 16) ssrow[lane] = (lane == 0) ? s : 0.f;
}

__device__ __forceinline__ void fold_item(unsigned char* lds, const float* __restrict__ w_in_pool, const float* __restrict__ w_pool_group, const float* __restrict__ pool_scale, const float* __restrict__ g_mix,
                                          bf16_t* WT, int item, int tid) {
    const int jl = item >> 7, grp = (item >> 5) & 3, k0 = (item & 31) * 32;
    float* wt = (float*)lds;
    float* wg = (float*)(lds + 32 * 196 * 4);
    unsigned short* ot = (unsigned short*)(lds + 32 * 196 * 4 + 48 * 192 * 4);
    const float* wsrc = w_in_pool + ((size_t)jl * D + k0) * D + grp * 192;
    const float* gsrc = w_pool_group + (size_t)(jl * 4 + grp) * 192 * 192;
    __syncthreads();
    for (int i = tid; i < 32 * 48; i += 512) { const int r = i / 48, c4 = i - r * 48; *(f32x4*)(wt + r * 196 + c4 * 4) = *(const f32x4*)(wsrc + (size_t)r * D + c4 * 4); }
    const int k = tid >> 4, cc = (tid & 15) * 12;
    float acc[12];
#pragma unroll
    for (int e = 0; e < 12; ++e) acc[e] = 0.f;
    for (int jc = 0; jc < 4; ++jc) {
        __syncthreads();
        for (int i = tid; i < 48 * 48; i += 512) *(f32x4*)(wg + i * 4) = *(const f32x4*)(gsrc + (size_t)jc * 48 * 192 + i * 4);
        __syncthreads();
#pragma unroll 4
        for (int jj = 0; jj < 48; ++jj) {
            const float a = wt[k * 196 + jc * 48 + jj];
            const f32x4 b0 = *(const f32x4*)(wg + jj * 192 + cc), b1 = *(const f32x4*)(wg + jj * 192 + cc + 4), b2 = *(const f32x4*)(wg + jj * 192 + cc + 8);
            acc[0] += a * b0.x; acc[1] += a * b0.y; acc[2] += a * b0.z; acc[3] += a * b0.w;
            acc[4] += a * b1.x; acc[5] += a * b1.y; acc[6] += a * b1.z; acc[7] += a * b1.w;
            acc[8] += a * b2.x; acc[9] += a * b2.y; acc[10] += a * b2.z; acc[11] += a * b2.w;
        }
    }
    const float gk = g_mix[(2 * jl) * D + k0 + k];
#pragma unroll
    for (int e = 0; e < 12; e += 2) { const float s0 = pool_scale[jl * 768 + grp * 192 + cc + e] * gk, s1 = pool_scale[jl * 768 + grp * 192 + cc + e + 1] * gk;
        const unsigned w = cvt_pk_bf16(acc[e] * s0, acc[e + 1] * s1); ot[(cc + e) * 40 + k] = (unsigned short)(w & 0xffffu); ot[(cc + e + 1) * 40 + k] = (unsigned short)(w >> 16); }
    __syncthreads();
    bf16_t* dst = WT + wt_in(2 * jl) + (size_t)(grp * 192) * D + k0;
    for (int i = tid; i < 192 * 4; i += 512) { const int c = i >> 2, part = i & 3; *(u32x4*)(dst + (size_t)c * D + part * 8) = *(const u32x4*)((const unsigned char*)ot + c * 80 + part * 16); }
}

__device__ __forceinline__ void attend16(const unsigned char* kimg, const unsigned char* vt, const bf16x8 (&qf)[2], bool mask  , int klim, float mc, int lane, f32x4 (&O)[4], float& l) {
    const int r = lane & 15, G = lane >> 4;
    f32x4 s[16];
    const unsigned char* kp = kimg + r * 144 + G * 16;
#pragma unroll
    for (int kt = 0; kt < 16; ++kt) {
        s[kt] = (f32x4){0.f, 0.f, 0.f, 0.f};
#pragma unroll
        for (int ks = 0; ks < 2; ++ks) { const bf16x8 kf = *(const bf16x8*)(kp + kt * 16 * 144 + ks * 64); s[kt] = __builtin_amdgcn_mfma_f32_16x16x32_bf16(kf, qf[ks], s[kt], 0, 0, 0); }
    }
    const float c = 0.125f * 1.4426950408889634f;
    const int rel = klim - G * 4;
#pragma unroll
    for (int kt = 0; kt < 16; ++kt)
#pragma unroll
        for (int j = 0; j < 4; ++j) s[kt][j] = __builtin_amdgcn_exp2f(s[kt][j] * c - mc);
    if (__builtin_amdgcn_readfirstlane((int)mask)) {
        asm volatile("" ::: "memory");
#pragma unroll
        for (int kt = 0; kt < 16; ++kt)
#pragma unroll
            for (int j = 0; j < 4; ++j) s[kt][j] = (kt * 16 + j <= rel) ? s[kt][j] : 0.f;
        asm volatile("" ::: "memory");
    }
    float sum = 0.f;
#pragma unroll
    for (int kt = 0; kt < 16; ++kt) sum += (s[kt][0] + s[kt][1]) + (s[kt][2] + s[kt][3]);
    sum += __shfl_xor(sum, 16); sum += __shfl_xor(sum, 32);
#pragma unroll
    for (int dt = 0; dt < 4; ++dt) O[dt] = (f32x4){0.f, 0.f, 0.f, 0.f};
    const unsigned char* vp = vt + r * 528 + G * 16;
#pragma unroll
    for (int st = 0; st < 8; ++st) {
        union { u32x4 u; bf16x8 b; } pf;
        pf.u.x = cvt_pk_bf16(s[2 * st][0], s[2 * st][1]); pf.u.y = cvt_pk_bf16(s[2 * st][2], s[2 * st][3]);
        pf.u.z = cvt_pk_bf16(s[2 * st + 1][0], s[2 * st + 1][1]); pf.u.w = cvt_pk_bf16(s[2 * st + 1][2], s[2 * st + 1][3]);
#pragma unroll
        for (int dt = 0; dt < 4; ++dt) {
            const bf16x8 vf = *(const bf16x8*)(vp + dt * 16 * 528 + st * 64);
            O[dt] = __builtin_amdgcn_mfma_f32_16x16x32_bf16(vf, pf.b, O[dt], 0, 0, 0);
        }
    }
    l = sum;
}
__device__ __forceinline__ int vperm(int k) { return (k & ~31) + (((k & 15) >> 2) << 3) + (((k >> 4) & 1) << 2) + (k & 3); }
__device__ __forceinline__ void attend32(const unsigned char* kimg, const unsigned char* vt, const bf16x8 (&qa)[2], const bf16x8 (&qb)[2], bool mask  , int klimA, int klimB, float mc, int lane,
                                         f32x4 (&OA)[4], f32x4 (&OB)[4], float& lA, float& lB,
                                         bool pref, const bf16_t* nqbase, int nt0, int nt1, u32x4& nq0, u32x4& nq1, u32x4& nq2, u32x4& nq3) {
    const int r = lane & 15, G = lane >> 4;
    const float c = 0.125f * 1.4426950408889634f;
    const unsigned char* kp = kimg + r * 144 + G * 16;
    const unsigned char* vp = vt + r * 528 + G * 16;
    const int relA = klimA - G * 4, relB = klimB - G * 4;
    const bool mk = __builtin_amdgcn_readfirstlane((int)mask);
    float sumA = 0.f, sumB = 0.f;
#pragma unroll
    for (int dt = 0; dt < 4; ++dt) { OA[dt] = (f32x4){0.f, 0.f, 0.f, 0.f}; OB[dt] = (f32x4){0.f, 0.f, 0.f, 0.f}; }
    bf16x8 kf[2][4], vf[2][4];
#pragma unroll
    for (int ks = 0; ks < 2; ++ks)
#pragma unroll
        for (int k4 = 0; k4 < 4; ++k4) kf[ks][k4] = *(const bf16x8*)(kp + k4 * 16 * 144 + ks * 64);
#define A32_CHUNK(ch, LAST) do { \
        f32x4 sa[4], sb[4]; \
        _Pragma("unroll") \
        for (int k4 = 0; k4 < 4; ++k4) { sa[k4] = (f32x4){-mc, -mc, -mc, -mc}; sb[k4] = (f32x4){-mc, -mc, -mc, -mc}; }    \
        __builtin_amdgcn_sched_barrier(0); \
        _Pragma("unroll") \
        for (int k4 = 0; k4 < 4; ++k4) { sa[k4] = __builtin_amdgcn_mfma_f32_16x16x32_bf16(kf[0][k4], qa[0], sa[k4], 0, 0, 0); sb[k4] = __builtin_amdgcn_mfma_f32_16x16x32_bf16(kf[0][k4], qb[0], sb[k4], 0, 0, 0); } \
        __builtin_amdgcn_sched_barrier(0); \
        _Pragma("unroll") \
        for (int k4 = 0; k4 < 4; ++k4) { sa[k4] = __builtin_amdgcn_mfma_f32_16x16x32_bf16(kf[1][k4], qa[1], sa[k4], 0, 0, 0); sb[k4] = __builtin_amdgcn_mfma_f32_16x16x32_bf16(kf[1][k4], qb[1], sb[k4], 0, 0, 0); } \
        __builtin_amdgcn_sched_barrier(0); \
         \
        const int chn = ch < 3 ? ch + 1 : 3; \
        _Pragma("unroll") \
        for (int dt = 0; dt < 4; ++dt) vf[0][dt] = *(const bf16x8*)(vp + dt * 16 * 528 + (ch * 2) * 64); \
        __builtin_amdgcn_sched_barrier(0); \
        _Pragma("unroll") \
        for (int k4 = 0; k4 < 4; ++k4) \
        _Pragma("unroll") \
            for (int j = 0; j < 4; ++j) { sa[k4][j] = __builtin_amdgcn_exp2f(sa[k4][j]); sb[k4][j] = __builtin_amdgcn_exp2f(sb[k4][j]); } \
        if (mk) { \
            asm volatile("" ::: "memory"); \
        _Pragma("unroll") \
            for (int k4 = 0; k4 < 4; ++k4) \
        _Pragma("unroll") \
                for (int j = 0; j < 4; ++j) { sa[k4][j] = (k4 * 16 + j <= relA - ch * 64) ? sa[k4][j] : 0.f; sb[k4][j] = (k4 * 16 + j <= relB - ch * 64) ? sb[k4][j] : 0.f; } \
            asm volatile("" ::: "memory"); \
        } \
        _Pragma("unroll") \
        for (int k4 = 0; k4 < 4; ++k4) { sumA += (sa[k4][0] + sa[k4][1]) + (sa[k4][2] + sa[k4][3]); sumB += (sb[k4][0] + sb[k4][1]) + (sb[k4][2] + sb[k4][3]); } \
        union { u32x4 u; bf16x8 b; } pa[2], pb[2]; \
        _Pragma("unroll") \
        for (int s2 = 0; s2 < 2; ++s2) { \
            pa[s2].u.x = cvt_pk_bf16(sa[2 * s2][0], sa[2 * s2][1]); pa[s2].u.y = cvt_pk_bf16(sa[2 * s2][2], sa[2 * s2][3]); pa[s2].u.z = cvt_pk_bf16(sa[2 * s2 + 1][0], sa[2 * s2 + 1][1]); pa[s2].u.w = cvt_pk_bf16(sa[2 * s2 + 1][2], sa[2 * s2 + 1][3]); \
            pb[s2].u.x = cvt_pk_bf16(sb[2 * s2][0], sb[2 * s2][1]); pb[s2].u.y = cvt_pk_bf16(sb[2 * s2][2], sb[2 * s2][3]); pb[s2].u.z = cvt_pk_bf16(sb[2 * s2 + 1][0], sb[2 * s2 + 1][1]); pb[s2].u.w = cvt_pk_bf16(sb[2 * s2 + 1][2], sb[2 * s2 + 1][3]); \
        } \
        __builtin_amdgcn_sched_barrier(0); \
        if (!(LAST)) { \
        _Pragma("unroll") \
        for (int ks = 0; ks < 2; ++ks)                \
        _Pragma("unroll") \
            for (int k4 = 0; k4 < 4; ++k4) kf[ks][k4] = *(const bf16x8*)(kp + (chn * 4 + k4) * 16 * 144 + ks * 64); \
        } \
        _Pragma("unroll") \
        for (int dt = 0; dt < 4; ++dt) vf[1][dt] = *(const bf16x8*)(vp + dt * 16 * 528 + (ch * 2 + 1) * 64); \
        __builtin_amdgcn_sched_barrier(0); \
        _Pragma("unroll") \
        for (int dt = 0; dt < 4; ++dt) { OA[dt] = __builtin_amdgcn_mfma_f32_16x16x32_bf16(vf[0][dt], pa[0].b, OA[dt], 0, 0, 0); OB[dt] = __builtin_amdgcn_mfma_f32_16x16x32_bf16(vf[0][dt], pb[0].b, OB[dt], 0, 0, 0); } \
        __builtin_amdgcn_sched_barrier(0); \
        _Pragma("unroll") \
        for (int dt = 0; dt < 4; ++dt) { OA[dt] = __builtin_amdgcn_mfma_f32_16x16x32_bf16(vf[1][dt], pa[1].b, OA[dt], 0, 0, 0); OB[dt] = __builtin_amdgcn_mfma_f32_16x16x32_bf16(vf[1][dt], pb[1].b, OB[dt], 0, 0, 0); } \
        __builtin_amdgcn_sched_barrier(0); \
 \
    } while (0)
#pragma unroll 1
    for (int ch = 0; ch < 3; ++ch) A32_CHUNK(ch, false);
    if (pref) {
        nq0 = *(const u32x4*)(nqbase + (size_t)nt0 * 64); nq1 = *(const u32x4*)(nqbase + (size_t)nt0 * 64 + 32);
        nq2 = *(const u32x4*)(nqbase + (size_t)nt1 * 64); nq3 = *(const u32x4*)(nqbase + (size_t)nt1 * 64 + 32);
    }
    A32_CHUNK(3, true);
#undef A32_CHUNK
    sumA += __shfl_xor(sumA, 16); sumA += __shfl_xor(sumA, 32); sumB += __shfl_xor(sumB, 16); sumB += __shfl_xor(sumB, 32);
    lA = sumA; lB = sumB;
}
__device__ __forceinline__ void store_o_row(f32x4 (&O)[4], float linv, bf16_t* row, int G, bool doit = true) {
    unsigned y[4][4];
#pragma unroll
    for (int j = 0; j < 4; ++j) {
        unsigned r0 = __float_as_uint(O[0][j] * linv), r1 = __float_as_uint(O[1][j] * linv), r2 = __float_as_uint(O[2][j] * linv), r3 = __float_as_uint(O[3][j] * linv);
        u32x2 a = __builtin_amdgcn_permlane32_swap(r0, r2, false, false); r0 = a.x; r2 = a.y;
        u32x2 c = __builtin_amdgcn_permlane32_swap(r1, r3, false, false); r1 = c.x; r3 = c.y;
        u32x2 e = __builtin_amdgcn_permlane16_swap(r0, r1, false, false); r0 = e.x; r1 = e.y;
        u32x2 f = __builtin_amdgcn_permlane16_swap(r2, r3, false, false); r2 = f.x; r3 = f.y;
        y[0][j] = r0; y[1][j] = r1; y[2][j] = r2; y[3][j] = r3;
    }
    u32x4 w0, w1;
    w0.x = cvt_pk_bf16(__uint_as_float(y[0][0]), __uint_as_float(y[0][1])); w0.y = cvt_pk_bf16(__uint_as_float(y[0][2]), __uint_as_float(y[0][3]));
    w0.z = cvt_pk_bf16(__uint_as_float(y[1][0]), __uint_as_float(y[1][1])); w0.w = cvt_pk_bf16(__uint_as_float(y[1][2]), __uint_as_float(y[1][3]));
    w1.x = cvt_pk_bf16(__uint_as_float(y[2][0]), __uint_as_float(y[2][1])); w1.y = cvt_pk_bf16(__uint_as_float(y[2][2]), __uint_as_float(y[2][3]));
    w1.z = cvt_pk_bf16(__uint_as_float(y[3][0]), __uint_as_float(y[3][1])); w1.w = cvt_pk_bf16(__uint_as_float(y[3][2]), __uint_as_float(y[3][3]));
    if (doit) { *(u32x4*)(row + 16 * G) = w0; *(u32x4*)(row + 16 * G + 8) = w1; }
}
__device__ __forceinline__ float gain_absmax(const float* g, int lane) {
    float v = fabsf(g[lane]);
#pragma unroll
    for (int o = 1; o < 64; o <<= 1) v = fmaxf(v, __shfl_xor(v, o));
    return v;
}

__device__ __forceinline__ void memattn_phase(unsigned char* lds, const bf16_t* H, int ldh, int qoff, const bf16_t* memKV, int layer, const float* qgain, const float* kgain, bf16_t* AO, int bid, int G, int tid) {
    const int lane = tid & 63, wave = tid >> 6, r = lane & 15, Gq = lane >> 4;
    unsigned char* kimg = lds; unsigned char* vt = lds + 36864;
    const float mc = 64.0f * gain_absmax(qgain, lane) * gain_absmax(kgain, lane) * (0.125f * 1.4426950408889634f);
    for (int combo = bid & 7; combo < 8; combo += 8) {
        const int b = combo >> 2, head = combo & 3;
        __syncthreads();
        {
            const int key = tid >> 1, half = tid & 1;
            const bf16_t* src = memKV + (size_t)(b * 256 + key) * 2048 + layer * 512 + head * 64 + half * 32;
            float kv[32], vv[32];
#pragma unroll
            for (int i = 0; i < 4; ++i) { unpack8(*(const u32x4*)(src + 8 * i), kv + 8 * i); unpack8(*(const u32x4*)(src + 256 + 8 * i), vv + 8 * i); }
            float sq = 0.f;
#pragma unroll
            for (int i = 0; i < 32; ++i) sq += kv[i] * kv[i];
            sq += dpp_f<DPP_XOR1>(sq);
            const float rs = rsqrtf(sq * (1.0f / 64.0f) + 1e-6f);
#pragma unroll
            for (int i = 0; i < 32; ++i) kv[i] = kv[i] * rs * kgain[half * 32 + i];
#pragma unroll
            for (int i = 0; i < 4; ++i) *(u32x4*)(kimg + key * 144 + half * 64 + i * 16) = pack8(kv + 8 * i);
#pragma unroll
            for (int i = 0; i < 32; i += 2) { const unsigned w = cvt_pk_bf16(vv[i], vv[i + 1]); *(unsigned short*)(vt + (half * 32 + i) * 528 + vperm(key) * 2) = (unsigned short)(w & 0xffffu); *(unsigned short*)(vt + (half * 32 + i + 1) * 528 + vperm(key) * 2) = (unsigned short)(w >> 16); }
        }
        __syncthreads();
        for (int tile = bid >> 3; tile < SEQ / 256; tile += (G >> 3)) {
            bf16x8 qf[2][2];
#pragma unroll
            for (int s2 = 0; s2 < 2; ++s2) {
                const int t = tile * 256 + s2 * 128 + wave * 16 + r;
                const bf16_t* qrow = H + (size_t)(b * SEQ + t) * ldh + qoff + head * 64 + Gq * 8;
                float q0[8], q1[8];
                unpack8(*(const u32x4*)(qrow), q0); unpack8(*(const u32x4*)(qrow + 32), q1);
                float sq = 0.f;
#pragma unroll
                for (int i = 0; i < 8; ++i) sq += q0[i] * q0[i] + q1[i] * q1[i];
                sq += __shfl_xor(sq, 16); sq += __shfl_xor(sq, 32);
                const float rs = rsqrtf(sq * (1.0f / 64.0f) + 1e-6f);
#pragma unroll
                for (int i = 0; i < 8; ++i) { q0[i] = q0[i] * (rs * QSCALE) * qgain[Gq * 8 + i]; q1[i] = q1[i] * (rs * QSCALE) * qgain[32 + Gq * 8 + i]; }
                union { u32x4 u; bf16x8 b; } f0, f1; f0.u = pack8(q0); f1.u = pack8(q1);
                qf[s2][0] = f0.b; qf[s2][1] = f1.b;
            }
            f32x4 OA[4], OB[4]; float lA, lB;
            u32x4 d0, d1, d2, d3;
            attend32(kimg, vt, qf[0], qf[1], false, 255, 255, mc, lane, OA, OB, lA, lB, false, nullptr, 0, 0, d0, d1, d2, d3);
            const int tA = tile * 256 + wave * 16 + r;
            store_o_row(OA, 1.0f / lA, AO + (size_t)(b * SEQ + tA) * 1024 + 768 + head * 64, Gq);
            store_o_row(OB, 1.0f / lB, AO + (size_t)(b * SEQ + tA + 128) * 1024 + 768 + head * 64, Gq);
        }
    }
}

__device__ __forceinline__ void pool_phase(const bf16_t* __restrict__ H, bf16_t* __restrict__ AO, int gtid, int gthreads) {
    for (int idx = gtid; idx < (M / 32) * 96; idx += gthreads) {
        const int c = idx % 96, run = idx / 96, t0 = run * 32, tl0 = t0 & (SEQ - 1);
        const int w = 2 << (c / 24);
        const bf16_t* base = H + (size_t)t0 * 1024 + c * 8;
        float S[8], v[8];
#pragma unroll
        for (int e = 0; e < 8; ++e) S[e] = 0.f;
        for (int j = 1; j < w; ++j) if (tl0 - j >= 0) { unpack8(*(const u32x4*)(base - (size_t)j * 1024), v);
#pragma unroll
            for (int e = 0; e < 8; ++e) S[e] += v[e]; }
#pragma unroll 1
        for (int i0 = 0; i0 < 32; i0 += 8) {
            u32x4 cur[8], old[8];
#pragma unroll
            for (int k = 0; k < 8; ++k) { cur[k] = *(const u32x4*)(base + (size_t)(i0 + k) * 1024);
                const int to = tl0 + i0 + k - w + 1; old[k] = (to >= 0) ? *(const u32x4*)(base + ((ptrdiff_t)(i0 + k - w + 1)) * 1024) : (u32x4){0u, 0u, 0u, 0u}; }
#pragma unroll
            for (int k = 0; k < 8; ++k) {
                const int tl = tl0 + i0 + k;
                unpack8(cur[k], v);
                const float inv = 1.0f / (float)min(tl + 1, w);
                float o[8], u[8];
#pragma unroll
                for (int e = 0; e < 8; ++e) { S[e] += v[e]; o[e] = S[e] * inv - v[e]; }
                *(u32x4*)(AO + (size_t)(t0 + i0 + k) * 1024 + c * 8) = pack8(o);
                unpack8(old[k], u);
#pragma unroll
                for (int e = 0; e < 8; ++e) S[e] -= u[e];
            }
        }
    }
}

__device__ __forceinline__ void moba_prep_phase(unsigned char* lds, const bf16_t* H, const float* cosT, const float* sinT, const float* qgain, const float* kgain,
                                                bf16_t* Qn, bf16_t* Kimg, bf16_t* VT, float* kmean, int bid, int G, int tid) {
    const int lane = tid & 63, wave = tid >> 6;
    float* red = (float*)lds;
    unsigned char* vts = lds + 8192;
    const int pit0 = (int)(((long)bid * (24 * 64)) / G), pit1 = (int)(((long)(bid + 1) * (24 * 64)) / G);
    float cs[32], sn[32];
    int cur_bn = -1;
    u32x4 raw[3][4];
    if (pit0 < pit1) { const int bn = pit0 / 12, h = pit0 - bn * 12; const bf16_t* hr = H + (size_t)((bn >> 6) * SEQ + (bn & 63) * 256 + (tid >> 1)) * NMOBA + h * 64 + (tid & 1) * 32;
#pragma unroll
        for (int which = 0; which < 3; ++which)
#pragma unroll
            for (int i = 0; i < 4; ++i) raw[which][i] = *(const u32x4*)(hr + which * 768 + 8 * i); }
    for (int pit = pit0; pit < pit1; ++pit) {
        const int bn = pit / 12, h = pit - bn * 12, b = bn >> 6, n = bn & 63, bh = b * 12 + h;
        const int tk = tid >> 1, half = tid & 1, t = n * 256 + tk;
        u32x4 nraw[3][4];
        { const int pn = (pit + 1 < pit1) ? pit + 1 : pit; const int bn2 = pn / 12, h2 = pn - bn2 * 12; const bf16_t* hr = H + (size_t)((bn2 >> 6) * SEQ + (bn2 & 63) * 256 + tk) * NMOBA + h2 * 64 + half * 32;
#pragma unroll
          for (int which = 0; which < 3; ++which)
#pragma unroll
              for (int i = 0; i < 4; ++i) nraw[which][i] = *(const u32x4*)(hr + which * 768 + 8 * i); }
        if (bn != cur_bn) {
            cur_bn = bn;
#pragma unroll
            for (int i = 0; i < 8; ++i) { const f32x4 a = *(const f32x4*)(cosT + (size_t)t * 32 + 4 * i), bq = *(const f32x4*)(sinT + (size_t)t * 32 + 4 * i);
                cs[4 * i] = a.x; cs[4 * i + 1] = a.y; cs[4 * i + 2] = a.z; cs[4 * i + 3] = a.w; sn[4 * i] = bq.x; sn[4 * i + 1] = bq.y; sn[4 * i + 2] = bq.z; sn[4 * i + 3] = bq.w; }
        }
        float x[32];
#pragma unroll
        for (int which = 0; which < 2; ++which) {
            const float* gn = which ? kgain : qgain;
#pragma unroll
            for (int i = 0; i < 4; ++i) unpack8(raw[which][i], x + 8 * i);
            float sq = 0.f;
#pragma unroll
            for (int i = 0; i < 32; ++i) sq += x[i] * x[i];
            sq += dpp_f<DPP_XOR1>(sq);
            const float rs = rsqrtf(sq * (1.0f / 64.0f) + 1e-6f);
#pragma unroll
            for (int i = 0; i < 32; ++i) { const float xn = x[i] * rs * gn[half * 32 + i]; const float other = dpp_f<DPP_XOR1>(xn); x[i] = half ? (xn * cs[i] + other * sn[i]) : (xn * cs[i] - other * sn[i]); }
            bf16_t* dst = which ? (Kimg + (size_t)(bh * 64 + n) * 16384 + tk * 64 + half * 32) : (Qn + ((size_t)bh * SEQ + t) * 64 + half * 32);
            if (!which) {
#pragma unroll
                for (int i = 0; i < 32; ++i) x[i] *= QSCALE;
            }
#pragma unroll
            for (int i = 0; i < 4; ++i) *(u32x4*)(dst + 8 * i) = pack8(x + 8 * i);
            if (which) {
#pragma unroll
                for (int i = 0; i < 32; ++i) { float s = x[i]; s += dpp_f<DPP_XOR2>(s); s += dpp_f<DPP_ROR4>(s); s += dpp_f<DPP_ROR8>(s); if ((lane & 15) < 2) red[(wave * 4 + (lane >> 4)) * 64 + half * 32 + i] = s; }
            }
        }
        {
#pragma unroll
            for (int i = 0; i < 4; ++i) { const u32x4 w = raw[2][i]; const unsigned ww[4] = {w.x, w.y, w.z, w.w};
#pragma unroll
                for (int e = 0; e < 4; ++e) { *(unsigned short*)(vts + (half * 32 + 8 * i + 2 * e) * 528 + vperm(tk) * 2) = (unsigned short)(ww[e] & 0xffffu); *(unsigned short*)(vts + (half * 32 + 8 * i + 2 * e + 1) * 528 + vperm(tk) * 2) = (unsigned short)(ww[e] >> 16); } }
        }
        __syncthreads();
        if (tid < 64) { float s = 0.f;
#pragma unroll
            for (int w = 0; w < 32; ++w) s += red[w * 64 + tid];
            kmean[(size_t)(bh * 64 + n) * 64 + tid] = s * (1.0f / 256.0f); }
        bf16_t* vdst = VT + (size_t)(bh * 64 + n) * 16384;
#pragma unroll
        for (int i = 0; i < 4; ++i) { const int ch = tid + 512 * i, d = ch >> 5, part = ch & 31; *(u32x4*)(vdst + d * 256 + part * 8) = *(const u32x4*)(vts + d * 528 + part * 16); }
        __syncthreads();
#pragma unroll
        for (int which = 0; which < 3; ++which)
#pragma unroll
            for (int i = 0; i < 4; ++i) raw[which][i] = nraw[which][i];
    }
}

__device__ __forceinline__ int list_off(int n) { return 256 * (63 * n - (n * (n - 1)) / 2); }
__device__ __forceinline__ void moba_gate_phase(unsigned char* lds, const bf16_t* Qn, const float* kmean, int* cnt, unsigned short* lists, int bid, int G, int tid) {
    float* km = (float*)lds;
    for (int i0 = bid; i0 < 768; i0 += G) {
        const int rr = i0 >> 8, bb = i0 & 255, c32 = bb & 31;
        const int chunk = rr == 0 ? c32 : (rr == 1 ? 31 - c32 : ((c32 + 16) & 31));
        const int bh = (bb >> 5) + 8 * rr;
        const int nrows = 2 * chunk + 1;
        __syncthreads();
        for (int i = tid; i < nrows * 16; i += 512) ((f32x4*)km)[i] = ((const f32x4*)(kmean + (size_t)bh * 64 * 64))[i];
        __syncthreads();
        const int t = chunk * 512 + tid;
        const int own = __builtin_amdgcn_readfirstlane(t >> 8);
        float q[64];
        const bf16_t* qrow = Qn + ((size_t)bh * SEQ + t) * 64;
#pragma unroll
        for (int i = 0; i < 8; ++i) unpack8(*(const u32x4*)(qrow + 8 * i), q + 8 * i);
        float v0 = -INFINITY, v1 = -INFINITY, v2 = -INFINITY; int i0s = 0, i1s = 0, i2s = 0;
        for (int n = 0; n < own; ++n) {
            const f32x4* kr = (const f32x4*)(km + n * 64);
            float g0 = 0.f, g1 = 0.f, g2 = 0.f, g3 = 0.f;
#pragma unroll
            for (int i = 0; i < 16; ++i) { const f32x4 kv = kr[i]; g0 += q[4 * i] * kv.x; g1 += q[4 * i + 1] * kv.y; g2 += q[4 * i + 2] * kv.z; g3 += q[4 * i + 3] * kv.w; }
            const float g = (g0 + g1) + (g2 + g3);
            if (g > v2) {
                if (g > v1) { v2 = v1; i2s = i1s; if (g > v0) { v1 = v0; i1s = i0s; v0 = g; i0s = n; } else { v1 = g; i1s = n; } }
                else { v2 = g; i2s = n; }
            }
        }
        const int nv = own < 3 ? own : 3;
        unsigned short* lb = lists + (size_t)bh * LIST_PER_BH;
        int* lcnt = (int*)(lds + 16384 + 1024); int* lbase = lcnt + 64;
        if (tid < 64) lcnt[tid] = 0;
        __syncthreads();
        int p0 = 0, p1 = 0, p2 = 0;
        if (nv > 0) p0 = atomicAdd(lcnt + i0s, 1);
        if (nv > 1) p1 = atomicAdd(lcnt + i1s, 1);
        if (nv > 2) p2 = atomicAdd(lcnt + i2s, 1);
        __syncthreads();
        if (tid < 64) { const int c = lcnt[tid]; lbase[tid] = c > 0 ? atomicAdd(cnt + bh * 64 + tid, c) : 0; }
        __syncthreads();
        if (nv > 0) lb[list_off(i0s) + lbase[i0s] + p0] = (unsigned short)((t << 2) | 0);
        if (nv > 1) lb[list_off(i1s) + lbase[i1s] + p1] = (unsigned short)((t << 2) | 1);
        if (nv > 2) lb[list_off(i2s) + lbase[i2s] + p2] = (unsigned short)((t << 2) | 2);
    }
}

struct MobaItem { int bhn, h, n, g, c, nlg; };
__device__ __forceinline__ MobaItem moba_decode(const int* pre, const int* cnt, int bsel, int item) {
    int lo = 0, hi = 768;
    while (hi - lo > 1) { const int mid = (lo + hi) >> 1; if (pre[mid] <= item) lo = mid; else hi = mid; }
    MobaItem it; it.h = lo >> 6; it.n = lo & 63; it.g = item - pre[lo]; it.bhn = (bsel * 12 + it.h) * 64 + it.n; it.c = cnt[it.bhn]; it.nlg = (it.c + 255) >> 8; return it;
}
__device__ __forceinline__ MobaItem moba_fetch(const int* tab, int k) { const int4 v = *(const int4*)(tab + 4 * k); MobaItem it; it.bhn = v.x; it.g = v.y; it.c = v.z; it.nlg = v.w; it.n = v.x & 63; it.h = (v.x >> 6) % 12; return it; }
__device__ __forceinline__ void moba_entry(const MobaItem& it, const unsigned short* lists, int s, int wave, int r, int& t, int& slot, int& klim, bool& valid) {
    const int loc = s * 128 + wave * 16 + r;
    if (it.g < it.nlg) { const int idx = it.g * 256 + loc; valid = idx < it.c; const unsigned e = lists[(size_t)(it.bhn >> 6) * LIST_PER_BH + list_off(it.n) + (valid ? idx : 0)]; t = (int)(e >> 2); slot = (int)(e & 3u); klim = 255; }
    else { klim = loc; t = it.n * 256 + loc; slot = 3; valid = true; }
}
__device__ __forceinline__ void moba_attn_phase(unsigned char* lds, int bsel, const bf16_t* Qn, const bf16_t* Kimg, const bf16_t* VT, const int* cnt, const unsigned short* lists,
                                                bf16_t* Opart, float* lse, const float* qgain, const float* kgain, int vcu, int G, int tid, int mode = 0) {
    const int lane = tid & 63, wave = tid >> 6, r = lane & 15, Gq = lane >> 4;
    const float mc = 64.0f * gain_absmax(qgain, lane) * gain_absmax(kgain, lane) * (0.125f * 1.4426950408889634f);
    int* pre = (int*)(lds + 141312); int* wtot = (int*)(lds + 144392);
    __syncthreads();
    {
        int v0 = 0, v1 = 0;
        if (tid < 384) { const int l0 = 2 * tid, l1 = 2 * tid + 1;
            const int c0 = cnt[(bsel * 12 + (l0 >> 6)) * 64 + (l0 & 63)], c1 = cnt[(bsel * 12 + (l1 >> 6)) * 64 + (l1 & 63)];
            v0 = ((c0 + 255) >> 8) + 1; v1 = ((c1 + 255) >> 8) + 1; }
        const int local = v0 + v1; int incl = local;
#pragma unroll
        for (int o = 1; o < 64; o <<= 1) { const int tt = __shfl_up(incl, o); if (lane >= o) incl += tt; }
        if (lane == 63) wtot[wave] = incl;
        __syncthreads();
        int base = 0;
        for (int w = 0; w < wave; ++w) base += wtot[w];
        const int excl = base + incl - local;
        if (tid < 384) { pre[2 * tid] = excl; pre[2 * tid + 1] = excl + v0; if (tid == 383) pre[768] = excl + local; }
        __syncthreads();
    }
    const int total = pre[768];
    const int it_begin = (int)(((long)vcu * total) / G), it_end = (int)(((long)(vcu + 1) * total) / G);
#define MOBA_ITEM_OF(k) (it_begin + (k))
    int item = MOBA_ITEM_OF(0);
    int* tab = (int*)(lds + 144432);
    if (tid < 64) { const int it = MOBA_ITEM_OF(tid); if (it < it_end) { const MobaItem d = moba_decode(pre, cnt, bsel, it); tab[4 * tid] = d.bhn; tab[4 * tid + 1] = d.g; tab[4 * tid + 2] = d.c; tab[4 * tid + 3] = d.nlg; } }
    __syncthreads();
    if (item >= it_end) return;
    int kidx = 0;
    MobaItem cur = moba_fetch(tab, kidx);
    u32x4 kk[4], vv[4];
    {
        const bf16_t* ks = Kimg + (size_t)cur.bhn * 16384; const bf16_t* vs = VT + (size_t)cur.bhn * 16384;
#pragma unroll
        for (int i = 0; i < 4; ++i) { const int ch = tid + 512 * i; kk[i] = *(const u32x4*)(ks + ch * 8); vv[i] = *(const u32x4*)(vs + ch * 8); }
    }
    int t0, slot0, klim0, t1, slot1, klim1; bool valid0, valid1;
    moba_entry(cur, lists, 0, wave, r, t0, slot0, klim0, valid0);
    moba_entry(cur, lists, 1, wave, r, t1, slot1, klim1, valid1);
    u32x4 q0a, q0b, q1a, q1b;
    { const bf16_t* qr0 = Qn + ((size_t)(cur.bhn >> 6) * SEQ + t0) * 64 + Gq * 8; const bf16_t* qr1 = Qn + ((size_t)(cur.bhn >> 6) * SEQ + t1) * 64 + Gq * 8;
      q0a = *(const u32x4*)(qr0); q0b = *(const u32x4*)(qr0 + 32); q1a = *(const u32x4*)(qr1); q1b = *(const u32x4*)(qr1 + 32); }
    int bufsel = 0; bool fresh = true;
    for (;;) {
        unsigned char* kimg = lds + bufsel * 70656; unsigned char* vt = kimg + 36864;
        if (fresh) {
#pragma unroll
            for (int i = 0; i < 4; ++i) { const int ch = tid + 512 * i; *(u32x4*)(kimg + (ch >> 3) * 144 + (ch & 7) * 16) = kk[i]; *(u32x4*)(vt + (ch >> 5) * 528 + (ch & 31) * 16) = vv[i]; }
            __syncthreads();
        }
        const int nitem = MOBA_ITEM_OF(kidx + 1); const bool has_next = nitem < it_end;
        MobaItem nxt = cur;
        if (has_next) nxt = moba_fetch(tab, kidx + 1);
        const bool nfresh = has_next && nxt.bhn != cur.bhn;
        if (nfresh) {
            const bf16_t* ks = Kimg + (size_t)nxt.bhn * 16384; const bf16_t* vs = VT + (size_t)nxt.bhn * 16384;
#pragma unroll
            for (int i = 0; i < 4; ++i) { const int ch = tid + 512 * i; kk[i] = *(const u32x4*)(ks + ch * 8); vv[i] = *(const u32x4*)(vs + ch * 8); }
        }
        int nt0 = 0, nslot0 = 0, nklim0 = 0, nt1 = 0, nslot1 = 0, nklim1 = 0; bool nvalid0 = false, nvalid1 = false;
        if (has_next) { moba_entry(nxt, lists, 0, wave, r, nt0, nslot0, nklim0, nvalid0); moba_entry(nxt, lists, 1, wave, r, nt1, nslot1, nklim1, nvalid1); }
        const int h = cur.h;
        u32x4 nqa = q0a, nqb = q0b, nqc = q1a, nqd = q1b; bool nq_done = false;
        if (__builtin_amdgcn_readfirstlane(__any((int)valid0))) {
            union { u32x4 u; bf16x8 b; } f0, f1, g0, g1; f0.u = q0a; f1.u = q0b; g0.u = q1a; g1.u = q1b;
            bf16x8 qa[2] = {f0.b, f1.b}, qb[2] = {g0.b, g1.b};
            f32x4 OA[4], OB[4]; float lA, lB;
            attend32(kimg, vt, qa, qb, cur.g >= cur.nlg, klim0, klim1, mc, lane, OA, OB, lA, lB, has_next, Qn + (size_t)(nxt.bhn >> 6) * SEQ * 64 + Gq * 8, nt0, nt1, nqa, nqb, nqc, nqd);
            nq_done = has_next;
            { const bool st = valid0 && mode == 0; const size_t pidx = ((size_t)t0 * 12 + h) * 4 + slot0; store_o_row(OA, 1.0f / lA, Opart + pidx * 64, Gq, st); if (st && Gq == 0) lse[pidx] = mc + __builtin_amdgcn_logf(lA); }
            { const bool st = valid1 && mode == 0; const size_t pidx = ((size_t)t1 * 12 + h) * 4 + slot1; store_o_row(OB, 1.0f / lB, Opart + pidx * 64, Gq, st); if (st && Gq == 0) lse[pidx] = mc + __builtin_amdgcn_logf(lB); }
        }
        if (!has_next) break;
        if (nq_done) { q0a = nqa; q0b = nqb; q1a = nqc; q1b = nqd; }
        else {
            const bf16_t* qr0 = Qn + ((size_t)(nxt.bhn >> 6) * SEQ + nt0) * 64 + Gq * 8; const bf16_t* qr1 = Qn + ((size_t)(nxt.bhn >> 6) * SEQ + nt1) * 64 + Gq * 8;
            q0a = *(const u32x4*)(qr0); q0b = *(const u32x4*)(qr0 + 32); q1a = *(const u32x4*)(qr1); q1b = *(const u32x4*)(qr1 + 32);
        }
        cur = nxt; item = nitem; if (nfresh) bufsel ^= 1; fresh = nfresh; ++kidx;
        t0 = nt0; slot0 = nslot0; klim0 = nklim0; valid0 = nvalid0; t1 = nt1; slot1 = nslot1; klim1 = nklim1; valid1 = nvalid1;
    }
}
#undef MOBA_ITEM_OF
__device__ __forceinline__ void moba_combine_phase(int bsel, const bf16_t* Opart, const float* lse, bf16_t* AO, int gtid, int gthreads) {
    for (int idx = gtid; idx < SEQ * 96; idx += gthreads) {
        const int chunk = idx & 7, th = idx >> 3, h = th % 12, t = th / 12, own = t >> 8, nv = own < 3 ? own : 3;
        const f32x4 ls = *(const f32x4*)(lse + (size_t)th * 4);
        float wv[4] = {nv > 0 ? ls.x : -INFINITY, nv > 1 ? ls.y : -INFINITY, nv > 2 ? ls.z : -INFINITY, ls.w};
        const float mx = fmaxf(fmaxf(wv[0], wv[1]), fmaxf(wv[2], wv[3]));
        float tot = 0.f;
#pragma unroll
        for (int j = 0; j < 4; ++j) { wv[j] = __builtin_amdgcn_exp2f(wv[j] - mx); tot += wv[j]; }
        const float inv = 1.0f / tot;
        float o[8];
#pragma unroll
        for (int e = 0; e < 8; ++e) o[e] = 0.f;
#pragma unroll
        for (int j = 0; j < 4; ++j) { if (j < nv || j == 3) { float v[8]; unpack8(*(const u32x4*)(Opart + ((size_t)th * 4 + j) * 64 + chunk * 8), v); const float wj = wv[j] * inv;
#pragma unroll
            for (int e = 0; e < 8; ++e) o[e] += wj * v[e]; } }
        *(u32x4*)(AO + (size_t)(bsel * SEQ + t) * 1024 + h * 64 + chunk * 8) = pack8(o);
    }
}

__global__ void __launch_bounds__(512, 2) fwd_kernel(Params p) {
    extern __shared__ __attribute__((aligned(16))) unsigned char lds[];
    cg::grid_group grid = cg::this_grid();
    const int tid = threadIdx.x, lane = tid & 63, wave = __builtin_amdgcn_readfirstlane(tid >> 6);
    const int G = gridDim.x, bid = blockIdx.x, gtid = bid * 512 + tid, gthreads = G * 512, gwave = bid * 8 + wave, gwaves = G * 8;
    unsigned char* ws = p.ws;
    bf16_t* WT = (bf16_t*)(ws + OFF_WT); bf16_t* xb = (bf16_t*)(ws + OFF_XB); bf16_t* Qn = (bf16_t*)p.out;     float* ss = (float*)(ws + OFF_SS);
    bf16_t* memb = (bf16_t*)(ws + OFF_MEMB); float* ssm = (float*)(ws + OFF_SSM); bf16_t* memKV = (bf16_t*)(ws + OFF_MEMKV);
    float* cosT = (float*)(ws + OFF_ROPE); float* sinT = cosT + (size_t)SEQ * 32; float* kmean = (float*)(ws + OFF_KMEAN); int* cntAll = (int*)(ws + OFF_CNT);
    bf16_t* H = (bf16_t*)(ws + OFF_H); float* Wtmp = (float*)(ws + OFF_H); bf16_t* AO = (bf16_t*)(ws + OFF_AO); bf16_t* Kimg = (bf16_t*)(ws + OFF_KIMG); bf16_t* VT = (bf16_t*)(ws + OFF_VT);
    unsigned short* lists = (unsigned short*)(ws + OFF_LIST); bf16_t* ACT = (bf16_t*)(ws + OFF_ACT); bf16_t* Opart = (bf16_t*)(ws + OFF_OPART); float* lse = (float*)(ws + OFF_LSE);
    const float* x_in = p.in[0]; const float* mem = p.in[1]; const float* g_mix = p.in[2]; const float* g_mem = p.in[3]; const float* g_mlp = p.in[4];
    const float* w_in_pool = p.in[5]; const float* w_pool_group = p.in[6]; const float* pool_scale = p.in[7]; const float* w_in_moba = p.in[8];
    const float* moba_q_gain = p.in[9]; const float* moba_k_gain = p.in[10]; const float* w_mem_kv = p.in[11]; const float* mem_q_gain = p.in[12]; const float* mem_k_gain = p.in[13];
    const float* w_out = p.in[14]; const float* w_ff1 = p.in[15]; const float* w_ff2 = p.in[16];
    float* xres = p.out;
    const int vcu = (G % 8 == 0) ? (bid % 8) * (G / 8) + bid / 8 : bid;
    const int lo = p.ph_lo, hi = p.ph_hi;
    int ph = 0;
    if (lo < 0) grid.sync();
#define PH_BEGIN if (ph >= lo && ph < hi) {
#define PH_END   if (ph + 1 < hi) xcd_barrier(xbar); } ++ph;
    auto LDSP = (PG8_LAS unsigned char*)lds;
    if (tid < 4) ((unsigned*)(lds + 147456 - 64))[tid] = 0u;
    __syncthreads();
    XcdBarrier xbar = xcd_barrier_post((unsigned*)(ws + OFF_BAR), (volatile LAS unsigned*)(lds + 147456 - 64));

    PH_BEGIN
    {
        float* scr = (float*)lds + wave * (64 * 33);
        int base = 0;
        for (int j = 0; j < 2; ++j) transpose_job(w_in_moba + (size_t)j * D * NMOBA, NMOBA, D, NMOBA, g_mix + (2 * j + 1) * D, WT + wt_in(2 * j + 1), scr, base, gwave, gwaves, lane);
        for (int i = 0; i < 4; ++i) transpose_job(w_mem_kv + (size_t)i * D * 512, 512, D, 512, g_mem + i * D, WT + WT_MEM + (size_t)i * 512 * D, scr, base, gwave, gwaves, lane);
        for (int i = 0; i < 4; ++i) transpose_job(w_out + (size_t)i * D * D, D, D, D, nullptr, WT + WT_OUT + (size_t)i * D * D, scr, base, gwave, gwaves, lane);
        for (int i = 0; i < 4; ++i) transpose_job(w_ff1 + (size_t)i * D * DFF, DFF, D, DFF, g_mlp + i * D, WT + WT_FF1 + (size_t)i * DFF * D, scr, base, gwave, gwaves, lane);
        for (int i = 0; i < 4; ++i) transpose_job(w_ff2 + (size_t)i * DFF * D, D, DFF, D, nullptr, WT + WT_FF2 + (size_t)i * D * DFF, scr, base, gwave, gwaves, lane);
        for (int j = 0; j < 2; ++j) transpose_job(w_in_pool + (size_t)j * D * D + 768, D, D, 256, g_mix + (2 * j) * D, WT + wt_in(2 * j) + (size_t)768 * D, scr, base, gwave, gwaves, lane);
        for (int row = gwave; row < 512; row += gwaves) row_to_bf16(mem + (size_t)row * D, memb + (size_t)row * D, ssm + (size_t)row * 16, lane);
        for (int idx = gtid; idx < SEQ * 32; idx += gthreads) { const int pos = idx >> 5, i = idx & 31; const float inv = powf(10000.0f, -(float)(2 * i) / 64.0f); const float ang = (float)pos * inv; cosT[idx] = cosf(ang); sinT[idx] = sinf(ang); }
        for (int idx = gtid; idx < 4 * 1536; idx += gthreads) cntAll[idx] = 0;
        __syncthreads();
        for (int item = bid; item < 256; item += G) fold_item(lds, w_in_pool, w_pool_group, pool_scale, g_mix, WT, item, tid);
    }
    PH_END
    PH_BEGIN
    {
        if (bid >= 16) { const int gw2 = (bid - 16) * 8 + wave, ngw2 = (G - 16) * 8; for (int row = gw2; row < M; row += ngw2) row_to_bf16(x_in + (size_t)row * D, xb + (size_t)row * D, ss + (size_t)row * 16, lane); }
        pg8::Gemm g{memb, WT + WT_MEM, 512, 2048, D}; pg8::StaticOrder S; S.init(512, 2048, G, bid);
        pg8::EpiScale<0> E{memKV, 2048, ssm};
        pg8::gemm_phase<pg8::EpiScale<0>, pg8::StaticOrder, true, true>(LDSP, g, S, E);
    }
    PH_END
#pragma unroll 1
    for (int layer = 0; layer < DEPTH; ++layer) {
        const int j = layer >> 1; const bool moba = layer & 1;
        const int nin = moba ? NMOBA : D;
        PH_BEGIN
        {
            pg8::Gemm g{xb, WT + wt_in(layer), M, nin, D}; pg8::StaticOrder S; S.init(M, nin, G, bid);
            pg8::EpiScale<0> E{H, nin, ss};
            pg8::gemm_phase<pg8::EpiScale<0>, pg8::StaticOrder, true, true>(LDSP, g, S, E);
        }
        PH_END
        if (!moba) {
            PH_BEGIN
            pool_phase(H, AO, launder(gtid), gthreads);
            memattn_phase(lds, H, D, 768, memKV, layer, mem_q_gain + layer * 64, mem_k_gain + layer * 64, AO, bid, G, launder(tid));
            PH_END
        } else {
            int* cnt = cntAll + j * 1536;
            PH_BEGIN
            moba_prep_phase(lds, H, cosT, sinT, moba_q_gain + j * 64, moba_k_gain + j * 64, Qn, Kimg, VT, kmean, bid, G, launder(tid));
            memattn_phase(lds, H, NMOBA, 2304, memKV, layer, mem_q_gain + layer * 64, mem_k_gain + layer * 64, AO, bid, G, launder(tid));
            PH_END
            PH_BEGIN
            moba_gate_phase(lds, Qn, kmean, cnt, lists, bid, G, launder(tid));
            PH_END
#pragma unroll 1
            for (int bsel = 0; bsel < NB; ++bsel) {
                PH_BEGIN
                moba_attn_phase(lds, bsel, Qn, Kimg, VT, cnt, lists, Opart, lse, moba_q_gain + j * 64, moba_k_gain + j * 64, vcu, G, launder(tid));
                PH_END
                PH_BEGIN
                moba_combine_phase(bsel, Opart, lse, AO, launder(gtid), gthreads);
                PH_END
            }
        }
        PH_BEGIN
        {
            __syncthreads();
            pg8::Gemm g{AO, WT + WT_OUT + (size_t)layer * D * D, M, D, D}; pg8::StaticOrder S; S.init(M, D, G, bid);
            pg8::EpiResid E{nullptr, xb, ss};
            pg8::gemm_phase<pg8::EpiResid, pg8::StaticOrder, true, true>(LDSP, g, S, E);
        }
        PH_END
        PH_BEGIN
        {
            pg8::Gemm g{xb, WT + WT_FF1 + (size_t)layer * DFF * D, M, DFF, D}; pg8::StaticOrder S; S.init(M, DFF, G, bid);
            pg8::EpiScale<1> E{ACT, DFF, ss};
            pg8::gemm_phase<pg8::EpiScale<1>, pg8::StaticOrder, true, true>(LDSP, g, S, E);
        }
        PH_END
        PH_BEGIN
        {
            pg8::Gemm g{ACT, WT + WT_FF2 + (size_t)layer * D * DFF, M, D, DFF}; pg8::StaticOrder S; S.init(M, D, G, bid);
            pg8::EpiResid E{layer == DEPTH - 1 ? xres : nullptr, xb, ss};
            pg8::gemm_phase<pg8::EpiResid, pg8::StaticOrder, true, true>(LDSP, g, S, E);
        }
        PH_END
    }
#undef PH_BEGIN
#undef PH_END
}
constexpr int NPHASES = 2 + 2 * 5 + 2 * 10;

extern "C" void kernel_launch(void* const* d_in, const int* in_sizes, int n_in, void* d_out, int out_size, void* d_ws, size_t ws_size, hipStream_t stream) {
    static int grid = 0;
    if (grid == 0) {
        if (n_in != 17 || out_size != M * D || ws_size < WS_END) { fprintf(stderr, "kernel_launch: unexpected shapes (n_in %d out %d ws %zu need %zu)\n", n_in, out_size, ws_size, (size_t)WS_END); grid = -1; return; }
        int dev = 0, cus = 0, per_cu = 0;
        hipGetDevice(&dev); hipDeviceGetAttribute(&cus, hipDeviceAttributeMultiprocessorCount, dev);
        hipFuncSetAttribute((const void*)fwd_kernel, hipFuncAttributeMaxDynamicSharedMemorySize, LDS_BYTES);
        hipOccupancyMaxActiveBlocksPerMultiprocessor(&per_cu, (const void*)fwd_kernel, 512, LDS_BYTES);
        (void)hipGetLastError();
        if (per_cu < 1) per_cu = 1;
        grid = cus * per_cu;
    }
    if (grid < 0) return;
    if (hipMemsetAsync((char*)d_ws + OFF_BAR, 0, 16384, stream) != hipSuccess) { fprintf(stderr, "memset failed\n"); return; }
    Params p{};
    for (int i = 0; i < 17; ++i) p.in[i] = (const float*)d_in[i];
    p.out = (float*)d_out; p.ws = (unsigned char*)d_ws;
#if MK_SINGLE
    p.ph_lo = 0; p.ph_hi = NPHASES;
    { void* args[] = {&p}; hipError_t e = hipLaunchCooperativeKernel((const void*)fwd_kernel, dim3(grid), dim3(512), args, LDS_BYTES, stream);
      if (e != hipSuccess) fprintf(stderr, "cooperative launch failed: %s (grid %d)\n", hipGetErrorString(e), grid); }
#else
    for (int ph = 0; ph < NPHASES; ++ph) {
        p.ph_lo = ph; p.ph_hi = ph + 1; void* args[] = {&p};
        hipError_t e = hipLaunchCooperativeKernel((const void*)fwd_kernel, dim3(grid), dim3(512), args, LDS_BYTES, stream);
        if (e != hipSuccess) { fprintf(stderr, "launch %d failed: %s (grid %d)\n", ph, hipGetErrorString(e), grid); break; }
    }
#endif
}
```

```cpp
#include <hip/hip_runtime.h>
#include <hip/hip_cooperative_groups.h>
#include <cstdio>
#include <cstdint>
namespace cg = cooperative_groups;
#ifndef MK_SINGLE
#define MK_SINGLE 1
#endif
namespace pg8 {
#define PG8_LAS __attribute__((address_space(3)))
typedef unsigned short bf16_t;
typedef short bf16x8 __attribute__((ext_vector_type(8)));
typedef float f32x4 __attribute__((ext_vector_type(4)));
typedef unsigned u32x4 __attribute__((ext_vector_type(4)));
constexpr int BM = 256, BK = 64, HALF = 128, HTB = HALF * BK * 2  , STAGE_BYTES = 8 * HTB, NXCD = 8, WGM = 4;

__host__ __device__ __forceinline__ int lds_byte(int r, int c) { const int st = (r >> 4) * 2 + (c >> 5), rr = r & 15, cc = c & 31, ob = rr * 64 + cc * 2; return st * 1024 + (ob ^ (((ob >> 9) & 1) << 5)); }
__host__ __device__ __forceinline__ void stage_rc(int b, int& R, int& C) { const int st = b / 1024, sb = b % 1024, swz = sb ^ (((sb >> 9) & 1) << 5); R = (st >> 1) * 16 + swz / 64; C = (st & 1) * 32 + (swz % 64) / 2; }
__host__ __device__ __forceinline__ int perm32(int rho) { const int n = rho >> 4, i = rho & 15; return 8 * (i >> 2) + 4 * n + (i & 3); }

struct Unit { int pm, pn; };
struct Gemm { const bf16_t* A; const bf16_t* Bt; int M, N, K; };

struct StaticOrder {
    int nM, nN, nwg, G, c;
    __host__ __device__ void init(int M, int N, int G_, int c_) { nM = M / BM; nN = N / BM; nwg = nM * nN; G = G_; c = c_; }
    __host__ __device__ bool next(int i, Unit& u) const {
        const long L = (long)i * G + c; if (L >= nwg) return false;
        int wgid = (int)L; { const int q = nwg / NXCD, r = nwg % NXCD, xcd = wgid % NXCD, off = wgid / NXCD; wgid = (xcd < r ? xcd * (q + 1) : r * (q + 1) + (xcd - r) * q) + off; }
        const int nig = WGM * nN, gid = wgid / nig, fm = gid * WGM, gsz = (nM - fm) < WGM ? (nM - fm) : WGM;
        u.pm = fm + ((wgid % nig) % gsz); u.pn = (wgid % nig) / gsz; return true;
    }
    __device__ __forceinline__ void a_ready(const Unit&) const {}
    __device__ __forceinline__ void done(const Unit&) const {}
};

__device__ __forceinline__ unsigned cvt_pk_bf16(float lo, float hi) { unsigned r; asm volatile("v_cvt_pk_bf16_f32 %0, %1, %2" : "=v"(r) : "v"(lo), "v"(hi)); return r; }

template <int ACT> struct EpiScale {
    static constexpr bool PERM = true, AFTER_DRAIN = false;
    bf16_t* O; int ldc; const float* ss;
    __device__ __forceinline__ void operator()(const f32x4 (&acc)[2][2][4][2], const Unit& u, int wr, int wc, int fr, int fq) const {
        const int row0 = u.pm * BM + wr * 64 + fr, col0 = u.pn * BM + wc * 32 + 8 * fq;
#pragma unroll
        for (int ai = 0; ai < 2; ++ai)
#pragma unroll
            for (int m = 0; m < 4; ++m) {
                const int row = row0 + ai * HALF + m * 16;
                const f32x4* sp = (const f32x4*)(ss + (size_t)row * 16);
                const f32x4 a0 = sp[0], a1 = sp[1], a2 = sp[2], a3 = sp[3];
                const float tot = ((a0.x + a0.y) + (a0.z + a0.w)) + ((a1.x + a1.y) + (a1.z + a1.w)) + ((a2.x + a2.y) + (a2.z + a2.w)) + ((a3.x + a3.y) + (a3.z + a3.w));
                const float rs = rsqrtf(tot * (1.0f / 1024.0f) + 1e-6f);
                bf16_t* rowp = O + (size_t)row * ldc + col0;
#pragma unroll
                for (int bj = 0; bj < 2; ++bj) {
                    f32x4 v0 = acc[ai][bj][m][0] * rs, v1 = acc[ai][bj][m][1] * rs;
                    if (ACT == 1) {
#pragma unroll
                        for (int e = 0; e < 4; ++e) { float a = fmaxf(v0[e], 0.f); v0[e] = a * a; float b = fmaxf(v1[e], 0.f); v1[e] = b * b; }
                    }
                    u32x4 w; w.x = cvt_pk_bf16(v0[0], v0[1]); w.y = cvt_pk_bf16(v0[2], v0[3]); w.z = cvt_pk_bf16(v1[0], v1[1]); w.w = cvt_pk_bf16(v1[2], v1[3]);
                    *(u32x4*)(rowp + bj * HALF) = w;
                }
            }
    }
};
struct EpiResid {
    static constexpr bool PERM = true, AFTER_DRAIN = false;
    float* xout; bf16_t* xb; float* ss;
    __device__ __forceinline__ void operator()(const f32x4 (&acc)[2][2][4][2], const Unit& u, int wr, int wc, int fr, int fq) const {
        const unsigned row0 = u.pm * BM + wr * 64 + fr, col0 = u.pn * BM + wc * 32 + 8 * fq;
        char* xo = (char*)xout; char* xbp = (char*)xb; char* ssp = (char*)ss;
        const unsigned ssoff = (unsigned)(u.pn * 4 + wc) * 4u;
#pragma unroll
        for (int ai = 0; ai < 2; ++ai)
#pragma unroll
            for (int m = 0; m < 4; ++m) {
                const unsigned row = row0 + ai * HALF + m * 16;
                const unsigned hoff = (row * 1024u + col0) * 2u;
                float sq = 0.f;
#pragma unroll
                for (int bj = 0; bj < 2; ++bj) {
                    const u32x4 xw = *(const u32x4*)(xbp + hoff + bj * (HALF * 2));
                    f32x4 v0, v1;
                    v0[0] = __uint_as_float(xw.x << 16) + acc[ai][bj][m][0][0]; v0[1] = __uint_as_float(xw.x & 0xffff0000u) + acc[ai][bj][m][0][1];
                    v0[2] = __uint_as_float(xw.y << 16) + acc[ai][bj][m][0][2]; v0[3] = __uint_as_float(xw.y & 0xffff0000u) + acc[ai][bj][m][0][3];
                    v1[0] = __uint_as_float(xw.z << 16) + acc[ai][bj][m][1][0]; v1[1] = __uint_as_float(xw.z & 0xffff0000u) + acc[ai][bj][m][1][1];
                    v1[2] = __uint_as_float(xw.w << 16) + acc[ai][bj][m][1][2]; v1[3] = __uint_as_float(xw.w & 0xffff0000u) + acc[ai][bj][m][1][3];
                    if (xout) { *(f32x4*)(xo + 2u * hoff + bj * (HALF * 4)) = v0; *(f32x4*)(xo + 2u * hoff + bj * (HALF * 4) + 16) = v1; }
                    u32x4 w; w.x = cvt_pk_bf16(v0[0], v0[1]); w.y = cvt_pk_bf16(v0[2], v0[3]); w.z = cvt_pk_bf16(v1[0], v1[1]); w.w = cvt_pk_bf16(v1[2], v1[3]);
                    *(u32x4*)(xbp + hoff + bj * (HALF * 2)) = w;
                    sq += (v0[0] * v0[0] + v0[1] * v0[1]) + (v0[2] * v0[2] + v0[3] * v0[3]) + (v1[0] * v1[0] + v1[1] * v1[1]) + (v1[2] * v1[2] + v1[3] * v1[3]);
                }
                sq += __shfl_xor(sq, 16); sq += __shfl_xor(sq, 32);
                if (fq == 0) *(float*)(ssp + row * 64u + ssoff) = sq;
            }
    }
};

template <class Epi, class Sched, bool ALIGN_EPI = false, bool SP2 = false>
__device__ __forceinline__ void gemm_phase(PG8_LAS unsigned char* lds, const Gemm g, const Sched& S, const Epi& E) {
    int tid_l = threadIdx.x; asm volatile("" : "+v"(tid_l));
    const int tid = tid_l, wid = __builtin_amdgcn_readfirstlane(tid >> 6), lane = tid & 63, wr = wid >> 2, wc = wid & 3, fr = lane & 15, fq = lane >> 4;
    const int K = g.K, nt = K / BK;
    unsigned voffA[2], voffB[2];
#pragma unroll
    for (int i = 0; i < 2; ++i) { int R, C; stage_rc(tid * 16 + i * 8192, R, C); const int Rb = Epi::PERM ? ((R & ~31) + perm32(R & 31)) : R;
        voffA[i] = (unsigned)(R * K + C) * 2u; voffB[i] = (unsigned)(Rb * K + C) * 2u; }
    const size_t kstep = (size_t)(BK * 2);
    const size_t hstep = (size_t)HALF * K * 2;
    const size_t tstep = 2 * hstep;
    const unsigned ldsw = (unsigned)wid * 1024u;
    const int aoff = lds_byte(wr * 64 + fr, fq * 8), boff = lds_byte(wc * 32 + fr, fq * 8);
#define PG8_SA(b, h) (((b) * 2 + (h)) * HTB)
#define PG8_SB(b, h) ((4 + (b) * 2 + (h)) * HTB)
#define PG8_STAGE(bufoff, gbase, voff) do { _Pragma("unroll") for (int _i = 0; _i < 2; ++_i) \
        __builtin_amdgcn_global_load_lds((const unsigned*)((const char*)(gbase) + (voff)[_i]), (PG8_LAS unsigned*)(lds + (bufoff) + ldsw + _i * 8192), 16, 0, 0); } while (0)
#define PG8_LDA(dst, b, h) do { _Pragma("unroll") for (int m = 0; m < 4; ++m) _Pragma("unroll") for (int k = 0; k < 2; ++k) dst[m][k] = *(const PG8_LAS bf16x8*)(lds + PG8_SA(b, h) + aoff + m * 2048 + k * 1024); } while (0)
#define PG8_LDB(dst, b, h) do { _Pragma("unroll") for (int n = 0; n < 2; ++n) _Pragma("unroll") for (int k = 0; k < 2; ++k) dst[n][k] = *(const PG8_LAS bf16x8*)(lds + PG8_SB(b, h) + boff + n * 2048 + k * 1024); } while (0)
#define PG8_MMA(ai, bj, At, Bt) do { __builtin_amdgcn_s_setprio(1); _Pragma("unroll") for (int m = 0; m < 4; ++m) _Pragma("unroll") for (int n = 0; n < 2; ++n) _Pragma("unroll") for (int k = 0; k < 2; ++k) \
        acc[ai][bj][m][n] = __builtin_amdgcn_mfma_f32_16x16x32_bf16(Bt[n][k], At[m][k], acc[ai][bj][m][n], 0, 0, 0); __builtin_amdgcn_s_setprio(0); } while (0)
#define PG8_WAIT_V(n) asm volatile("s_waitcnt vmcnt(" #n ")" ::: "memory")
#define PG8_WAIT_L(n) asm volatile("s_waitcnt lgkmcnt(" #n ")" ::: "memory")
#define PG8_BAR __builtin_amdgcn_s_barrier()
#define PG8_SCHED __builtin_amdgcn_sched_barrier(0)
    Unit cur, nxt; int ui = 0;
    if (!S.next(0, cur)) return;
    f32x4 acc[2][2][4][2];
#pragma unroll
    for (int a = 0; a < 2; ++a)
#pragma unroll
        for (int b = 0; b < 2; ++b)
#pragma unroll
            for (int m = 0; m < 4; ++m)
#pragma unroll
                for (int n = 0; n < 2; ++n) acc[a][b][m][n] = (f32x4){0.f, 0.f, 0.f, 0.f};
    bf16x8 At[4][2], B0[2][2], B1[2][2];
    const char* cA = (const char*)g.A + (size_t)cur.pm * tstep; const char* cB = (const char*)g.Bt + (size_t)cur.pn * tstep;
    S.a_ready(cur);
    if constexpr (SP2) {
        PG8_STAGE(PG8_SB(0, 0), cB, voffB); PG8_STAGE(PG8_SB(0, 1), cB + hstep, voffB); PG8_STAGE(PG8_SA(0, 0), cA, voffA); PG8_STAGE(PG8_SA(0, 1), cA + hstep, voffA);
        if (wr == 1) PG8_BAR;
        PG8_WAIT_V(2); PG8_BAR;
        PG8_STAGE(PG8_SB(1, 0), cB + kstep, voffB); PG8_STAGE(PG8_SA(1, 0), cA + kstep, voffA); PG8_STAGE(PG8_SB(1, 1), cB + hstep + kstep, voffB);
        PG8_WAIT_V(6); PG8_BAR;
    } else {
        PG8_STAGE(PG8_SB(0, 0), cB, voffB); PG8_STAGE(PG8_SA(0, 0), cA, voffA); PG8_STAGE(PG8_SB(0, 1), cB + hstep, voffB); PG8_STAGE(PG8_SA(0, 1), cA + hstep, voffA);
        if (wr == 1) PG8_BAR;
        PG8_WAIT_V(4); PG8_BAR;
        PG8_STAGE(PG8_SB(1, 0), cB + kstep, voffB); PG8_STAGE(PG8_SA(1, 0), cA + kstep, voffA); PG8_STAGE(PG8_SB(1, 1), cB + hstep + kstep, voffB);
        PG8_WAIT_V(6); PG8_BAR;
    }
    for (;;) {
        const bool has_next = S.next(ui + 1, nxt);
        const char* nA = has_next ? (const char*)g.A + (size_t)nxt.pm * tstep : cA; const char* nB = has_next ? (const char*)g.Bt + (size_t)nxt.pn * tstep : cB;
        for (int t = 0; t < nt; t += 2) {
            const bool last = (t == nt - 2);
            const char* a1 = cA + (size_t)(t + 1) * kstep;
            const char* a2 = last ? nA : cA + (size_t)(t + 2) * kstep; const char* b2 = last ? nB : cB + (size_t)(t + 2) * kstep;
            const char* a3 = a2 + kstep; const char* b3 = b2 + kstep;
            if (last && has_next) S.a_ready(nxt);
            if constexpr (SP2) {
            PG8_LDB(B0, 0, 0); PG8_LDB(B1, 0, 1); PG8_SCHED; PG8_LDA(At, 0, 0); PG8_STAGE(PG8_SA(1, 1), a1 + hstep, voffA);
            PG8_WAIT_V(8); PG8_WAIT_L(0); PG8_BAR; PG8_MMA(0, 0, At, B0); PG8_MMA(0, 1, At, B1); PG8_BAR; PG8_SCHED;
            PG8_LDA(At, 0, 1); PG8_STAGE(PG8_SB(0, 0), b2, voffB); PG8_STAGE(PG8_SB(0, 1), b2 + hstep, voffB); PG8_STAGE(PG8_SA(0, 0), a2, voffA);
            PG8_WAIT_V(8); PG8_WAIT_L(0); PG8_BAR; PG8_MMA(1, 0, At, B0); PG8_MMA(1, 1, At, B1); PG8_BAR; PG8_SCHED;
            PG8_LDB(B0, 1, 0); PG8_LDB(B1, 1, 1); PG8_SCHED; PG8_LDA(At, 1, 0); PG8_STAGE(PG8_SA(0, 1), a2 + hstep, voffA);
            PG8_WAIT_V(8); PG8_WAIT_L(0); PG8_BAR; PG8_MMA(0, 0, At, B0); PG8_MMA(0, 1, At, B1); PG8_BAR; PG8_SCHED;
            PG8_LDA(At, 1, 1); PG8_STAGE(PG8_SB(1, 0), b3, voffB); PG8_STAGE(PG8_SB(1, 1), b3 + hstep, voffB); PG8_STAGE(PG8_SA(1, 0), a3, voffA);
            PG8_WAIT_V(8); PG8_WAIT_L(0); PG8_BAR; PG8_MMA(1, 0, At, B0); PG8_MMA(1, 1, At, B1); PG8_BAR; PG8_SCHED;
            } else {
            PG8_LDB(B0, 0, 0); PG8_SCHED; PG8_LDA(At, 0, 0); PG8_STAGE(PG8_SA(1, 1), a1 + hstep, voffA);
            PG8_WAIT_L(8); PG8_BAR; PG8_WAIT_L(0); PG8_MMA(0, 0, At, B0); PG8_BAR; PG8_SCHED;
            PG8_LDB(B1, 0, 1); PG8_STAGE(PG8_SB(0, 0), b2, voffB);
            PG8_BAR; PG8_WAIT_L(0); PG8_MMA(0, 1, At, B1); PG8_BAR;
            PG8_LDA(At, 0, 1); PG8_STAGE(PG8_SA(0, 0), a2, voffA);
            PG8_BAR; PG8_WAIT_L(0); PG8_MMA(1, 0, At, B0); PG8_BAR; PG8_SCHED;
            PG8_STAGE(PG8_SB(0, 1), b2 + hstep, voffB);
            PG8_WAIT_V(6); PG8_BAR; PG8_MMA(1, 1, At, B1); PG8_BAR;
            PG8_LDB(B0, 1, 0); PG8_SCHED; PG8_LDA(At, 1, 0); PG8_STAGE(PG8_SA(0, 1), a2 + hstep, voffA);
            PG8_WAIT_L(8); PG8_BAR; PG8_WAIT_L(0); PG8_MMA(0, 0, At, B0); PG8_BAR; PG8_SCHED;
            PG8_LDB(B1, 1, 1); PG8_STAGE(PG8_SB(1, 0), b3, voffB);
            PG8_BAR; PG8_WAIT_L(0); PG8_MMA(0, 1, At, B1); PG8_BAR;
            PG8_LDA(At, 1, 1); PG8_STAGE(PG8_SA(1, 0), a3, voffA);
            PG8_BAR; PG8_WAIT_L(0); PG8_MMA(1, 0, At, B0); PG8_BAR; PG8_SCHED;
            PG8_STAGE(PG8_SB(1, 1), b3 + hstep, voffB);
            PG8_WAIT_V(6); PG8_BAR; PG8_MMA(1, 1, At, B1); PG8_BAR;
            }
        }
        if constexpr (ALIGN_EPI) { if (wr == 0) PG8_BAR; }
        if constexpr (!Epi::AFTER_DRAIN) { E(acc, cur, wr, wc, fr, fq); S.done(cur); }
        if (!has_next) break;
#pragma unroll
        for (int a = 0; a < 2; ++a)
#pragma unroll
            for (int b = 0; b < 2; ++b)
#pragma unroll
                for (int m = 0; m < 4; ++m)
#pragma unroll
                    for (int n = 0; n < 2; ++n) acc[a][b][m][n] = (f32x4){0.f, 0.f, 0.f, 0.f};
        cur = nxt; cA = nA; cB = nB; ++ui;
        if constexpr (ALIGN_EPI) { if (wr == 1) PG8_BAR; }
    }
    PG8_WAIT_V(0);
    if constexpr (!ALIGN_EPI) { if (wr == 0) PG8_BAR; }
    PG8_BAR;
    if constexpr (Epi::AFTER_DRAIN) { E.fused(acc, cur, wr, wc, fr, fq, lds, wid, lane); S.done(cur); }
#undef PG8_SA
#undef PG8_SB
#undef PG8_STAGE
#undef PG8_LDA
#undef PG8_LDB
#undef PG8_MMA
#undef PG8_WAIT_V
#undef PG8_WAIT_L
#undef PG8_BAR
#undef PG8_SCHED
}
}
#define XB_TMO      128
#define XB_XCNT(j)  (256  + 64 * (j))
#define XB_XSUB(j)  (1280 + 64 * (j))
#define XB_XGEN(j)  (2304 + 64 * (j))
#define XB_TOP      3328
#define XB_TOPGEN   3392
#define XCD_BAR_WORDS 3456
#define XB_SPIN_CAP (1u << 18)
#define LAS __attribute__((address_space(3)))

__device__ __forceinline__ unsigned xb_ld(unsigned* p)              { return __hip_atomic_load(p, __ATOMIC_RELAXED, __HIP_MEMORY_SCOPE_AGENT); }
__device__ __forceinline__ unsigned xb_add(unsigned* p, unsigned v) { return __hip_atomic_fetch_add(p, v, __ATOMIC_RELAXED, __HIP_MEMORY_SCOPE_AGENT); }
__device__ __forceinline__ unsigned xb_xcc_id() { return (unsigned)__builtin_amdgcn_s_getreg((3 << 11) | 20) & 0xFu; }
#define XB_SPIN(cond, bar) do { unsigned _sp = 0; while (cond) { __builtin_amdgcn_s_sleep(1); \
    if ((++_sp & 255u) == 0u) { if (xb_ld(&(bar)[XB_TMO])) break; if (_sp > XB_SPIN_CAP) { atomicAdd(&(bar)[XB_TMO], 1u); break; } } } } while (0)

struct XcdBarrier {
    unsigned* bar; unsigned x;
    volatile LAS unsigned* st;
};

__device__ __forceinline__ XcdBarrier xcd_barrier_post(unsigned* bar, volatile LAS unsigned* st) {
    XcdBarrier b; b.bar = bar; b.x = xb_xcc_id(); b.st = st;
    if (threadIdx.x == 0) (void)xb_add(&bar[XB_XCNT(b.x)], 1u);
    return b;
}
__device__ __forceinline__ void xcd_barrier_complete(unsigned* bar, unsigned x, unsigned& nloc, unsigned& nx) {
    const unsigned G = gridDim.x * gridDim.y * gridDim.z;
    unsigned sum, cnt, mine, sp = 0u;
    for (;;) {
        sum = 0u; cnt = 0u; mine = 0u;
#pragma unroll
        for (unsigned j = 0; j < 16; ++j) { const unsigned c = xb_ld(&bar[XB_XCNT(j)]); sum += c; cnt += (c > 0u) ? 1u : 0u; mine = (j == x) ? c : mine; }
        if (sum == G) break;
        __builtin_amdgcn_s_sleep(1);
        if ((++sp & 255u) == 0u) { if (xb_ld(&bar[XB_TMO])) break; if (sp > XB_SPIN_CAP) { atomicAdd(&bar[XB_TMO], 1u); break; } }
    }
    nloc = mine > 0u ? mine : 1u; nx = cnt > 0u ? cnt : 1u;
}

__device__ __forceinline__ void xcd_barrier(const XcdBarrier& b) {
    asm volatile("s_waitcnt vmcnt(0)" ::: "memory");
    __syncthreads();
    if (threadIdx.x == 0) {
        unsigned* bar = b.bar;
        __builtin_amdgcn_s_waitcnt(0);
        unsigned nloc = b.st[0], nx = b.st[1];
        if (nloc == 0u) { xcd_barrier_complete(bar, b.x, nloc, nx); b.st[0] = nloc; b.st[1] = nx; }
        const unsigned old = xb_add(&bar[XB_XSUB(b.x)], 1u);
        const unsigned gen = old / nloc;
        if (old + 1u == (gen + 1u) * nloc) {
            __builtin_amdgcn_fence(__ATOMIC_RELEASE, "agent");
            asm volatile("s_waitcnt vmcnt(0)" ::: "memory");
            const unsigned og = xb_add(&bar[XB_TOP], 1u);
            const unsigned tg = og / nx;
            if (og + 1u == (tg + 1u) * nx) xb_add(&bar[XB_TOPGEN], 1u);
            else XB_SPIN(xb_ld(&bar[XB_TOPGEN]) == tg, bar);
            __builtin_amdgcn_fence(__ATOMIC_ACQUIRE, "agent");
            xb_add(&bar[XB_XGEN(b.x)], 1u);
            asm volatile("s_waitcnt vmcnt(0)" ::: "memory");
        } else {
            XB_SPIN(xb_ld(&bar[XB_XGEN(b.x)]) == gen, bar);
            __builtin_amdgcn_fence(__ATOMIC_ACQUIRE, "agent");
            asm volatile("s_waitcnt vmcnt(0)" ::: "memory");
        }
    }
    __syncthreads();
}


using pg8::bf16_t; using pg8::bf16x8; using pg8::f32x4; using pg8::u32x4; using pg8::cvt_pk_bf16;
typedef unsigned u32x2 __attribute__((ext_vector_type(2)));
constexpr int D = 1024, SEQ = 16384, NB = 2, M = NB * SEQ, DEPTH = 4, NH = 12, HD = 64, DFF = 4096, NMOBA = 2560;
constexpr int LDS_BYTES = 147456;
constexpr float QSCALE = 0.125f * 1.4426950408889634f;
constexpr int LIST_PER_BH = 256 * 2016;
constexpr size_t MB1 = 1048576;
constexpr size_t WT_ELEMS = 2 * (size_t)D * D + 2 * (size_t)NMOBA * D + 4 * (size_t)D * D + 4 * (size_t)DFF * D + 4 * (size_t)D * DFF + (size_t)2048 * D;
constexpr size_t OFF_WT = 0;
constexpr size_t OFF_XB = OFF_WT + WT_ELEMS * 2;
constexpr size_t OFF_SS = OFF_XB + (size_t)M * D * 2;
constexpr size_t OFF_MEMB = OFF_SS + (size_t)M * 16 * 4;
constexpr size_t OFF_SSM = OFF_MEMB + (size_t)512 * D * 2;
constexpr size_t OFF_MEMKV = OFF_SSM + (size_t)512 * 16 * 4;
constexpr size_t OFF_ROPE = OFF_MEMKV + (size_t)512 * 2048 * 2;
constexpr size_t OFF_KMEAN = OFF_ROPE + (size_t)2 * SEQ * 32 * 4;
constexpr size_t OFF_CNT = OFF_KMEAN + (size_t)1536 * 64 * 4;
constexpr size_t OFF_BAR = OFF_CNT + 4 * 1536 * 4 + 4096;
constexpr size_t OFF_BIG = OFF_BAR + 16384;
static_assert(XCD_BAR_WORDS * 4 <= 16384, "barrier words");
constexpr size_t OFF_H = OFF_BIG;
constexpr size_t OFF_AO = OFF_H + (size_t)M * NMOBA * 2;
constexpr size_t OFF_KIMG = OFF_AO + (size_t)M * D * 2;
constexpr size_t OFF_VT = OFF_KIMG + (size_t)1536 * 16384 * 2;
constexpr size_t OFF_LIST = OFF_VT + (size_t)1536 * 16384 * 2;
constexpr size_t WS_END = OFF_LIST + (size_t)24 * LIST_PER_BH * 2;
constexpr size_t OFF_ACT = OFF_BIG;
static_assert(OFF_ACT + (size_t)M * DFF * 2 <= WS_END, "ACT overlay");
constexpr size_t OFF_OPART = OFF_H;
constexpr size_t OFF_LSE = OFF_OPART + (size_t)SEQ * 12 * 4 * 64 * 2;
static_assert(OFF_LSE + (size_t)SEQ * 12 * 4 * 4 <= OFF_AO, "partials overlay");
static_assert(WS_END <= (size_t)536870912, "workspace budget");
__host__ __device__ constexpr size_t wt_in(int layer) { return (size_t)(layer >> 1) * ((size_t)D * D + (size_t)NMOBA * D) + ((layer & 1) ? (size_t)D * D : 0); }
constexpr size_t WT_OUT = 2 * ((size_t)D * D + (size_t)NMOBA * D), WT_FF1 = WT_OUT + 4 * (size_t)D * D, WT_FF2 = WT_FF1 + 4 * (size_t)DFF * D, WT_MEM = WT_FF2 + 4 * (size_t)D * DFF;

struct Params { const float* in[17]; float* out; unsigned char* ws; int ph_lo, ph_hi; };

__device__ __forceinline__ void unpack8(const u32x4 w, float* f) {
    f[0] = __uint_as_float(w.x << 16); f[1] = __uint_as_float(w.x & 0xffff0000u); f[2] = __uint_as_float(w.y << 16); f[3] = __uint_as_float(w.y & 0xffff0000u);
    f[4] = __uint_as_float(w.z << 16); f[5] = __uint_as_float(w.z & 0xffff0000u); f[6] = __uint_as_float(w.w << 16); f[7] = __uint_as_float(w.w & 0xffff0000u);
}
__device__ __forceinline__ u32x4 pack8(const float* f) { u32x4 w; w.x = cvt_pk_bf16(f[0], f[1]); w.y = cvt_pk_bf16(f[2], f[3]); w.z = cvt_pk_bf16(f[4], f[5]); w.w = cvt_pk_bf16(f[6], f[7]); return w; }
__device__ __forceinline__ float wave_sum(float v) {
#pragma unroll
    for (int o = 1; o < 64; o <<= 1) v += __shfl_xor(v, o);
    return v;
}
#define LDS_FENCE() asm volatile("s_waitcnt lgkmcnt(0)" ::: "memory")
template <int CTRL> __device__ __forceinline__ float dpp_f(float x) { return __int_as_float(__builtin_amdgcn_update_dpp(0, __float_as_int(x), CTRL, 0xF, 0xF, true)); }
#define DPP_XOR1 0xB1
#define DPP_XOR2 0x4E
#define DPP_ROR4 0x124
#define DPP_ROR8 0x128
__device__ __forceinline__ int launder(int v) { asm volatile("" : "+v"(v)); return v; }

__device__ __forceinline__ void transpose_item(const float* __restrict__ W, int ldw, int K, int N, const float* __restrict__ g, bf16_t* __restrict__ WT, float* scr, int item, int lane) {
    const int nblk = N / 32, kb = item / nblk, nb = item - kb * nblk, k0 = 64 * kb, n0 = 32 * nb;
#pragma unroll 8
    for (int i = 0; i < 32; ++i) { const int kk = 2 * i + (lane >> 5); float v = W[(size_t)(k0 + kk) * ldw + n0 + (lane & 31)]; if (g) v *= g[k0 + kk]; scr[kk * 33 + (lane & 31)] = v; }
    LDS_FENCE();
    const int c = lane & 7;
#pragma unroll
    for (int j = 0; j < 4; ++j) { const int n = (lane >> 3) + 8 * j; const float* s = scr + (8 * c) * 33 + n;
        u32x4 o; o.x = cvt_pk_bf16(s[0 * 33], s[1 * 33]); o.y = cvt_pk_bf16(s[2 * 33], s[3 * 33]); o.z = cvt_pk_bf16(s[4 * 33], s[5 * 33]); o.w = cvt_pk_bf16(s[6 * 33], s[7 * 33]);
        *(u32x4*)(WT + (size_t)(n0 + n) * K + k0 + 8 * c) = o; }
    LDS_FENCE();
}
__device__ __forceinline__ void transpose_item2(const float* __restrict__ W, int ldw, int K, int N, const float* __restrict__ g, bf16_t* __restrict__ WT, float* scr, int itemA, int itemB, int lane) {
    const int nblk = N / 32;
    const int kbA = itemA / nblk, nbA = itemA - kbA * nblk, kA = 64 * kbA, nA = 32 * nbA;
    const int kbB = itemB / nblk, nbB = itemB - kbB * nblk, kB = 64 * kbB, nB = 32 * nbB;
    float va[32], vb[32];
#pragma unroll
    for (int i = 0; i < 32; ++i) { const int kk = 2 * i + (lane >> 5); va[i] = W[(size_t)(kA + kk) * ldw + nA + (lane & 31)]; vb[i] = W[(size_t)(kB + kk) * ldw + nB + (lane & 31)]; }
#pragma unroll
    for (int pass = 0; pass < 2; ++pass) {
        const int k0 = pass ? kB : kA, n0 = pass ? nB : nA;
#pragma unroll
        for (int i = 0; i < 32; ++i) { const int kk = 2 * i + (lane >> 5); float v = pass ? vb[i] : va[i]; if (g) v *= g[k0 + kk]; scr[kk * 33 + (lane & 31)] = v; }
        LDS_FENCE();
        const int c = lane & 7;
#pragma unroll
        for (int j = 0; j < 4; ++j) { const int n = (lane >> 3) + 8 * j; const float* s = scr + (8 * c) * 33 + n;
            u32x4 o; o.x = cvt_pk_bf16(s[0 * 33], s[1 * 33]); o.y = cvt_pk_bf16(s[2 * 33], s[3 * 33]); o.z = cvt_pk_bf16(s[4 * 33], s[5 * 33]); o.w = cvt_pk_bf16(s[6 * 33], s[7 * 33]);
            *(u32x4*)(WT + (size_t)(n0 + n) * K + k0 + 8 * c) = o; }
        LDS_FENCE();
    }
}
__device__ __forceinline__ void transpose_job(const float* W, int ldw, int K, int N, const float* g, bf16_t* WT, float* scr, int& base, int gwave, int gwaves, int lane) {
    const int nitems = (K / 64) * (N / 32);
    int start = (gwave - (base % gwaves) + gwaves) % gwaves;
    int it = start;
    for (; it + gwaves < nitems; it += 2 * gwaves) transpose_item2(W, ldw, K, N, g, WT, scr, it, it + gwaves, lane);
    if (it < nitems) transpose_item(W, ldw, K, N, g, WT, scr, it, lane);
    base += nitems;
}
__device__ __forceinline__ void row_to_bf16(const float* xrow, bf16_t* orow, float* ssrow, int lane) {
    const f32x4* xr = (const f32x4*)xrow + lane;
    f32x4 v[4]; float s = 0.f;
#pragma unroll
    for (int j = 0; j < 4; ++j) { v[j] = xr[64 * j]; s += (v[j].x * v[j].x + v[j].y * v[j].y) + (v[j].z * v[j].z + v[j].w * v[j].w); }
    s = wave_sum(s);
    u32x2* o8 = (u32x2*)orow + lane;
#pragma unroll
    for (int j = 0; j < 4; ++j) { u32x2 w; w.x = cvt_pk_bf16(v[j].x, v[j].y); w.y = cvt_pk_bf16(v[j].z, v[j].w); o8[64 * j] = w; }
    if (lane < 16) ssrow[lane] = (lane == 0) ? s : 0.f;
}
__device__ __forceinline__ void row2_to_bf16(const float* x0, const float* x1, bf16_t* o0, bf16_t* o1, float* ss0, float* ss1, int lane) {
    const f32x4* xr0 = (const f32x4*)x0 + lane; const f32x4* xr1 = (const f32x4*)x1 + lane;
    f32x4 v[4], w[4]; float s = 0.f, u = 0.f;
#pragma unroll
    for (int j = 0; j < 4; ++j) { v[j] = xr0[64 * j]; w[j] = xr1[64 * j]; }
#pragma unroll
    for (int j = 0; j < 4; ++j) { s += (v[j].x * v[j].x + v[j].y * v[j].y) + (v[j].z * v[j].z + v[j].w * v[j].w); u += (w[j].x * w[j].x + w[j].y * w[j].y) + (w[j].z * w[j].z + w[j].w * w[j].w); }
    s = wave_sum(s); u = wave_sum(u);
    u32x2* p0 = (u32x2*)o0 + lane; u32x2* p1 = (u32x2*)o1 + lane;
#pragma unroll
    for (int j = 0; j < 4; ++j) { u32x2 a; a.x = cvt_pk_bf16(v[j].x, v[j].y); a.y = cvt_pk_bf16(v[j].z, v[j].w); p0[64 * j] = a; u32x2 c; c.x = cvt_pk_bf16(w[j].x, w[j].y); c.y = cvt_pk_bf16(w[j].z, w[j].w); p1[64 * j] = c; }
    if (lane < 16) { ss0[lane] = (lane == 0) ? s : 0.f; ss1[lane] = (lane == 0) ? u : 0.f; }
}

__device__ __forceinline__ void fold_item(unsigned char* lds, const float* __restrict__ w_in_pool, const float* __restrict__ w_pool_group, const float* __restrict__ pool_scale, const float* __restrict__ g_mix,
                                          bf16_t* WT, int item, int tid) {
    const int jl = item >> 7, grp = (item >> 5) & 3, k0 = (item & 31) * 32;
    float* wt = (float*)lds;
    float* wg = (float*)(lds + 32 * 196 * 4);
    unsigned short* ot = (unsigned short*)(lds + 32 * 196 * 4 + 48 * 192 * 4);
    const float* wsrc = w_in_pool + ((size_t)jl * D + k0) * D + grp * 192;
    const float* gsrc = w_pool_group + (size_t)(jl * 4 + grp) * 192 * 192;
    __syncthreads();
    for (int i = tid; i < 32 * 48; i += 512) { const int r = i / 48, c4 = i - r * 48; *(f32x4*)(wt + r * 196 + c4 * 4) = *(const f32x4*)(wsrc + (size_t)r * D + c4 * 4); }
    const int k = tid >> 4, cc = (tid & 15) * 12;
    float acc[12];
#pragma unroll
    for (int e = 0; e < 12; ++e) acc[e] = 0.f;
    for (int jc = 0; jc < 4; ++jc) {
        __syncthreads();
        for (int i = tid; i < 48 * 48; i += 512) *(f32x4*)(wg + i * 4) = *(const f32x4*)(gsrc + (size_t)jc * 48 * 192 + i * 4);
        __syncthreads();
#pragma unroll 4
        for (int jj = 0; jj < 48; ++jj) {
            const float a = wt[k * 196 + jc * 48 + jj];
            const f32x4 b0 = *(const f32x4*)(wg + jj * 192 + cc), b1 = *(const f32x4*)(wg + jj * 192 + cc + 4), b2 = *(const f32x4*)(wg + jj * 192 + cc + 8);
            acc[0] += a * b0.x; acc[1] += a * b0.y; acc[2] += a * b0.z; acc[3] += a * b0.w;
            acc[4] += a * b1.x; acc[5] += a * b1.y; acc[6] += a * b1.z; acc[7] += a * b1.w;
            acc[8] += a * b2.x; acc[9] += a * b2.y; acc[10] += a * b2.z; acc[11] += a * b2.w;
        }
    }
    const float gk = g_mix[(2 * jl) * D + k0 + k];
#pragma unroll
    for (int e = 0; e < 12; e += 2) { const float s0 = pool_scale[jl * 768 + grp * 192 + cc + e] * gk, s1 = pool_scale[jl * 768 + grp * 192 + cc + e + 1] * gk;
        const unsigned w = cvt_pk_bf16(acc[e] * s0, acc[e + 1] * s1); ot[(cc + e) * 40 + k] = (unsigned short)(w & 0xffffu); ot[(cc + e + 1) * 40 + k] = (unsigned short)(w >> 16); }
    __syncthreads();
    bf16_t* dst = WT + wt_in(2 * jl) + (size_t)(grp * 192) * D + k0;
    for (int i = tid; i < 192 * 4; i += 512) { const int c = i >> 2, part = i & 3; *(u32x4*)(dst + (size_t)c * D + part * 8) = *(const u32x4*)((const unsigned char*)ot + c * 80 + part * 16); }
}

__device__ __forceinline__ void attend16(const unsigned char* kimg, const unsigned char* vt, const bf16x8 (&qf)[2], bool mask  , int klim, float mc, int lane, f32x4 (&O)[4], float& l) {
    const int r = lane & 15, G = lane >> 4;
    f32x4 s[16];
    const unsigned char* kp = kimg + r * 144 + G * 16;
#pragma unroll
    for (int kt = 0; kt < 16; ++kt) {
        s[kt] = (f32x4){0.f, 0.f, 0.f, 0.f};
#pragma unroll
        for (int ks = 0; ks < 2; ++ks) { const bf16x8 kf = *(const bf16x8*)(kp + kt * 16 * 144 + ks * 64); s[kt] = __builtin_amdgcn_mfma_f32_16x16x32_bf16(kf, qf[ks], s[kt], 0, 0, 0); }
    }
    const float c = 0.125f * 1.4426950408889634f;
    const int rel = klim - G * 4;
#pragma unroll
    for (int kt = 0; kt < 16; ++kt)
#pragma unroll
        for (int j = 0; j < 4; ++j) s[kt][j] = __builtin_amdgcn_exp2f(s[kt][j] * c - mc);
    if (__builtin_amdgcn_readfirstlane((int)mask)) {
        asm volatile("" ::: "memory");
#pragma unroll
        for (int kt = 0; kt < 16; ++kt)
#pragma unroll
            for (int j = 0; j < 4; ++j) s[kt][j] = (kt * 16 + j <= rel) ? s[kt][j] : 0.f;
        asm volatile("" ::: "memory");
    }
    float sum = 0.f;
#pragma unroll
    for (int kt = 0; kt < 16; ++kt) sum += (s[kt][0] + s[kt][1]) + (s[kt][2] + s[kt][3]);
    sum += __shfl_xor(sum, 16); sum += __shfl_xor(sum, 32);
#pragma unroll
    for (int dt = 0; dt < 4; ++dt) O[dt] = (f32x4){0.f, 0.f, 0.f, 0.f};
    const unsigned char* vp = vt + r * 528 + G * 16;
#pragma unroll
    for (int st = 0; st < 8; ++st) {
        union { u32x4 u; bf16x8 b; } pf;
        pf.u.x = cvt_pk_bf16(s[2 * st][0], s[2 * st][1]); pf.u.y = cvt_pk_bf16(s[2 * st][2], s[2 * st][3]);
        pf.u.z = cvt_pk_bf16(s[2 * st + 1][0], s[2 * st + 1][1]); pf.u.w = cvt_pk_bf16(s[2 * st + 1][2], s[2 * st + 1][3]);
#pragma unroll
        for (int dt = 0; dt < 4; ++dt) {
            const bf16x8 vf = *(const bf16x8*)(vp + dt * 16 * 528 + st * 64);
            O[dt] = __builtin_amdgcn_mfma_f32_16x16x32_bf16(vf, pf.b, O[dt], 0, 0, 0);
        }
    }
    l = sum;
}
__device__ __forceinline__ int vperm(int k) { return (k & ~31) + (((k & 15) >> 2) << 3) + (((k >> 4) & 1) << 2) + (k & 3); }
__device__ __forceinline__ void attend32(const unsigned char* kimg, const unsigned char* vt, const bf16x8 (&qa)[2], const bf16x8 (&qb)[2], bool mask  , int klimA, int klimB, float mc, int lane,
                                         f32x4 (&OA)[4], f32x4 (&OB)[4], float& lA, float& lB,
                                         bool pref, const bf16_t* nqbase, int nt0, int nt1, u32x4& nq0, u32x4& nq1, u32x4& nq2, u32x4& nq3) {
    const int r = lane & 15, G = lane >> 4;
    const float c = 0.125f * 1.4426950408889634f;
    const unsigned char* kp = kimg + r * 144 + G * 16;
    const unsigned char* vp = vt + r * 528 + G * 16;
    const int relA = klimA - G * 4, relB = klimB - G * 4;
    const bool mk = __builtin_amdgcn_readfirstlane((int)mask);
    float sumA = 0.f, sumB = 0.f;
#pragma unroll
    for (int dt = 0; dt < 4; ++dt) { OA[dt] = (f32x4){0.f, 0.f, 0.f, 0.f}; OB[dt] = (f32x4){0.f, 0.f, 0.f, 0.f}; }
    bf16x8 kf[2][4], vf[2][4];
#pragma unroll
    for (int ks = 0; ks < 2; ++ks)
#pragma unroll
        for (int k4 = 0; k4 < 4; ++k4) kf[ks][k4] = *(const bf16x8*)(kp + k4 * 16 * 144 + ks * 64);
#define A32_CHUNK(ch, LAST) do { \
        f32x4 sa[4], sb[4]; \
        _Pragma("unroll") \
        for (int k4 = 0; k4 < 4; ++k4) { sa[k4] = (f32x4){-mc, -mc, -mc, -mc}; sb[k4] = (f32x4){-mc, -mc, -mc, -mc}; }    \
        __builtin_amdgcn_sched_barrier(0); \
        _Pragma("unroll") \
        for (int k4 = 0; k4 < 4; ++k4) { sa[k4] = __builtin_amdgcn_mfma_f32_16x16x32_bf16(kf[0][k4], qa[0], sa[k4], 0, 0, 0); sb[k4] = __builtin_amdgcn_mfma_f32_16x16x32_bf16(kf[0][k4], qb[0], sb[k4], 0, 0, 0); } \
        __builtin_amdgcn_sched_barrier(0); \
        _Pragma("unroll") \
        for (int k4 = 0; k4 < 4; ++k4) { sa[k4] = __builtin_amdgcn_mfma_f32_16x16x32_bf16(kf[1][k4], qa[1], sa[k4], 0, 0, 0); sb[k4] = __builtin_amdgcn_mfma_f32_16x16x32_bf16(kf[1][k4], qb[1], sb[k4], 0, 0, 0); } \
        __builtin_amdgcn_sched_barrier(0); \
         \
        const int chn = ch < 3 ? ch + 1 : 3; \
        _Pragma("unroll") \
        for (int dt = 0; dt < 4; ++dt) vf[0][dt] = *(const bf16x8*)(vp + dt * 16 * 528 + (ch * 2) * 64); \
        __builtin_amdgcn_sched_barrier(0); \
        _Pragma("unroll") \
        for (int k4 = 0; k4 < 4; ++k4) \
        _Pragma("unroll") \
            for (int j = 0; j < 4; ++j) { sa[k4][j] = __builtin_amdgcn_exp2f(sa[k4][j]); sb[k4][j] = __builtin_amdgcn_exp2f(sb[k4][j]); } \
        if (mk) { \
            asm volatile("" ::: "memory"); \
        _Pragma("unroll") \
            for (int k4 = 0; k4 < 4; ++k4) \
        _Pragma("unroll") \
                for (int j = 0; j < 4; ++j) { sa[k4][j] = (k4 * 16 + j <= relA - ch * 64) ? sa[k4][j] : 0.f; sb[k4][j] = (k4 * 16 + j <= relB - ch * 64) ? sb[k4][j] : 0.f; } \
            asm volatile("" ::: "memory"); \
        } \
        _Pragma("unroll") \
        for (int k4 = 0; k4 < 4; ++k4) { sumA += (sa[k4][0] + sa[k4][1]) + (sa[k4][2] + sa[k4][3]); sumB += (sb[k4][0] + sb[k4][1]) + (sb[k4][2] + sb[k4][3]); } \
        union { u32x4 u; bf16x8 b; } pa[2], pb[2]; \
        _Pragma("unroll") \
        for (int s2 = 0; s2 < 2; ++s2) { \
            pa[s2].u.x = cvt_pk_bf16(sa[2 * s2][0], sa[2 * s2][1]); pa[s2].u.y = cvt_pk_bf16(sa[2 * s2][2], sa[2 * s2][3]); pa[s2].u.z = cvt_pk_bf16(sa[2 * s2 + 1][0], sa[2 * s2 + 1][1]); pa[s2].u.w = cvt_pk_bf16(sa[2 * s2 + 1][2], sa[2 * s2 + 1][3]); \
            pb[s2].u.x = cvt_pk_bf16(sb[2 * s2][0], sb[2 * s2][1]); pb[s2].u.y = cvt_pk_bf16(sb[2 * s2][2], sb[2 * s2][3]); pb[s2].u.z = cvt_pk_bf16(sb[2 * s2 + 1][0], sb[2 * s2 + 1][1]); pb[s2].u.w = cvt_pk_bf16(sb[2 * s2 + 1][2], sb[2 * s2 + 1][3]); \
        } \
        __builtin_amdgcn_sched_barrier(0); \
        if (!(LAST)) { \
        _Pragma("unroll") \
        for (int ks = 0; ks < 2; ++ks)                \
        _Pragma("unroll") \
            for (int k4 = 0; k4 < 4; ++k4) kf[ks][k4] = *(const bf16x8*)(kp + (chn * 4 + k4) * 16 * 144 + ks * 64); \
        } \
        _Pragma("unroll") \
        for (int dt = 0; dt < 4; ++dt) vf[1][dt] = *(const bf16x8*)(vp + dt * 16 * 528 + (ch * 2 + 1) * 64); \
        __builtin_amdgcn_sched_barrier(0); \
        _Pragma("unroll") \
        for (int dt = 0; dt < 4; ++dt) { OA[dt] = __builtin_amdgcn_mfma_f32_16x16x32_bf16(vf[0][dt], pa[0].b, OA[dt], 0, 0, 0); OB[dt] = __builtin_amdgcn_mfma_f32_16x16x32_bf16(vf[0][dt], pb[0].b, OB[dt], 0, 0, 0); } \
        __builtin_amdgcn_sched_barrier(0); \
        _Pragma("unroll") \
        for (int dt = 0; dt < 4; ++dt) { OA[dt] = __builtin_amdgcn_mfma_f32_16x16x32_bf16(vf[1][dt], pa[1].b, OA[dt], 0, 0, 0); OB[dt] = __builtin_amdgcn_mfma_f32_16x16x32_bf16(vf[1][dt], pb[1].b, OB[dt], 0, 0, 0); } \
        __builtin_amdgcn_sched_barrier(0); \
 \
    } while (0)
#pragma unroll 1
    for (int ch = 0; ch < 3; ++ch) A32_CHUNK(ch, false);
    if (pref) {
        nq0 = *(const u32x4*)(nqbase + (size_t)nt0 * 64); nq1 = *(const u32x4*)(nqbase + (size_t)nt0 * 64 + 32);
        nq2 = *(const u32x4*)(nqbase + (size_t)nt1 * 64); nq3 = *(const u32x4*)(nqbase + (size_t)nt1 * 64 + 32);
    }
    A32_CHUNK(3, true);
#undef A32_CHUNK
    sumA += __shfl_xor(sumA, 16); sumA += __shfl_xor(sumA, 32); sumB += __shfl_xor(sumB, 16); sumB += __shfl_xor(sumB, 32);
    lA = sumA; lB = sumB;
}
__device__ __forceinline__ void store_o_row(f32x4 (&O)[4], float linv, bf16_t* row, int G, bool doit = true) {
    unsigned y[4][4];
#pragma unroll
    for (int j = 0; j < 4; ++j) {
        unsigned r0 = __float_as_uint(O[0][j] * linv), r1 = __float_as_uint(O[1][j] * linv), r2 = __float_as_uint(O[2][j] * linv), r3 = __float_as_uint(O[3][j] * linv);
        u32x2 a = __builtin_amdgcn_permlane32_swap(r0, r2, false, false); r0 = a.x; r2 = a.y;
        u32x2 c = __builtin_amdgcn_permlane32_swap(r1, r3, false, false); r1 = c.x; r3 = c.y;
        u32x2 e = __builtin_amdgcn_permlane16_swap(r0, r1, false, false); r0 = e.x; r1 = e.y;
        u32x2 f = __builtin_amdgcn_permlane16_swap(r2, r3, false, false); r2 = f.x; r3 = f.y;
        y[0][j] = r0; y[1][j] = r1; y[2][j] = r2; y[3][j] = r3;
    }
    u32x4 w0, w1;
    w0.x = cvt_pk_bf16(__uint_as_float(y[0][0]), __uint_as_float(y[0][1])); w0.y = cvt_pk_bf16(__uint_as_float(y[0][2]), __uint_as_float(y[0][3]));
    w0.z = cvt_pk_bf16(__uint_as_float(y[1][0]), __uint_as_float(y[1][1])); w0.w = cvt_pk_bf16(__uint_as_float(y[1][2]), __uint_as_float(y[1][3]));
    w1.x = cvt_pk_bf16(__uint_as_float(y[2][0]), __uint_as_float(y[2][1])); w1.y = cvt_pk_bf16(__uint_as_float(y[2][2]), __uint_as_float(y[2][3]));
    w1.z = cvt_pk_bf16(__uint_as_float(y[3][0]), __uint_as_float(y[3][1])); w1.w = cvt_pk_bf16(__uint_as_float(y[3][2]), __uint_as_float(y[3][3]));
    if (doit) { *(u32x4*)(row + 16 * G) = w0; *(u32x4*)(row + 16 * G + 8) = w1; }
}
__device__ __forceinline__ float gain_absmax(const float* g, int lane) {
    float v = fabsf(g[lane]);
#pragma unroll
    for (int o = 1; o < 64; o <<= 1) v = fmaxf(v, __shfl_xor(v, o));
    return v;
}

__device__ __forceinline__ void memattn_phase(unsigned char* lds, const bf16_t* H, int ldh, int qoff, const bf16_t* memKV, int layer, const float* qgain, const float* kgain, bf16_t* AO, int bid, int G, int tid) {
    const int lane = tid & 63, wave = tid >> 6, r = lane & 15, Gq = lane >> 4;
    unsigned char* kimg = lds; unsigned char* vt = lds + 36864;
    const float mc = 64.0f * gain_absmax(qgain, lane) * gain_absmax(kgain, lane) * (0.125f * 1.4426950408889634f);
    for (int combo = bid & 7; combo < 8; combo += 8) {
        const int b = combo >> 2, head = combo & 3;
        __syncthreads();
        {
            const int key = tid >> 1, half = tid & 1;
            const bf16_t* src = memKV + (size_t)(b * 256 + key) * 2048 + layer * 512 + head * 64 + half * 32;
            float kv[32], vv[32];
#pragma unroll
            for (int i = 0; i < 4; ++i) { unpack8(*(const u32x4*)(src + 8 * i), kv + 8 * i); unpack8(*(const u32x4*)(src + 256 + 8 * i), vv + 8 * i); }
            float sq = 0.f;
#pragma unroll
            for (int i = 0; i < 32; ++i) sq += kv[i] * kv[i];
            sq += dpp_f<DPP_XOR1>(sq);
            const float rs = rsqrtf(sq * (1.0f / 64.0f) + 1e-6f);
#pragma unroll
            for (int i = 0; i < 32; ++i) kv[i] = kv[i] * rs * kgain[half * 32 + i];
#pragma unroll
            for (int i = 0; i < 4; ++i) *(u32x4*)(kimg + key * 144 + half * 64 + i * 16) = pack8(kv + 8 * i);
#pragma unroll
            for (int i = 0; i < 32; i += 2) { const unsigned w = cvt_pk_bf16(vv[i], vv[i + 1]); *(unsigned short*)(vt + (half * 32 + i) * 528 + vperm(key) * 2) = (unsigned short)(w & 0xffffu); *(unsigned short*)(vt + (half * 32 + i + 1) * 528 + vperm(key) * 2) = (unsigned short)(w >> 16); }
        }
        __syncthreads();
        for (int tile = bid >> 3; tile < SEQ / 256; tile += (G >> 3)) {
            bf16x8 qf[2][2];
#pragma unroll
            for (int s2 = 0; s2 < 2; ++s2) {
                const int t = tile * 256 + s2 * 128 + wave * 16 + r;
                const bf16_t* qrow = H + (size_t)(b * SEQ + t) * ldh + qoff + head * 64 + Gq * 8;
                float q0[8], q1[8];
                unpack8(*(const u32x4*)(qrow), q0); unpack8(*(const u32x4*)(qrow + 32), q1);
                float sq = 0.f;
#pragma unroll
                for (int i = 0; i < 8; ++i) sq += q0[i] * q0[i] + q1[i] * q1[i];
                sq += __shfl_xor(sq, 16); sq += __shfl_xor(sq, 32);
                const float rs = rsqrtf(sq * (1.0f / 64.0f) + 1e-6f);
#pragma unroll
                for (int i = 0; i < 8; ++i) { q0[i] = q0[i] * (rs * QSCALE) * qgain[Gq * 8 + i]; q1[i] = q1[i] * (rs * QSCALE) * qgain[32 + Gq * 8 + i]; }
                union { u32x4 u; bf16x8 b; } f0, f1; f0.u = pack8(q0); f1.u = pack8(q1);
                qf[s2][0] = f0.b; qf[s2][1] = f1.b;
            }
            f32x4 OA[4], OB[4]; float lA, lB;
            u32x4 d0, d1, d2, d3;
            attend32(kimg, vt, qf[0], qf[1], false, 255, 255, mc, lane, OA, OB, lA, lB, false, nullptr, 0, 0, d0, d1, d2, d3);
            const int tA = tile * 256 + wave * 16 + r;
            store_o_row(OA, 1.0f / lA, AO + (size_t)(b * SEQ + tA) * 1024 + 768 + head * 64, Gq);
            store_o_row(OB, 1.0f / lB, AO + (size_t)(b * SEQ + tA + 128) * 1024 + 768 + head * 64, Gq);
        }
    }
}

__device__ __forceinline__ void pool_phase(const bf16_t* __restrict__ H, bf16_t* __restrict__ AO, int gtid, int gthreads) {
    for (int idx = gtid; idx < (M / 32) * 96; idx += gthreads) {
        const int c = idx % 96, run = idx / 96, t0 = run * 32, tl0 = t0 & (SEQ - 1);
        const int w = 2 << (c / 24);
        const bf16_t* base = H + (size_t)t0 * 1024 + c * 8;
        float S[8], v[8];
#pragma unroll
        for (int e = 0; e < 8; ++e) S[e] = 0.f;
        for (int j = 1; j < w; ++j) if (tl0 - j >= 0) { unpack8(*(const u32x4*)(base - (size_t)j * 1024), v);
#pragma unroll
            for (int e = 0; e < 8; ++e) S[e] += v[e]; }
#pragma unroll 1
        for (int i0 = 0; i0 < 32; i0 += 8) {
            u32x4 cur[8], old[8];
#pragma unroll
            for (int k = 0; k < 8; ++k) { cur[k] = *(const u32x4*)(base + (size_t)(i0 + k) * 1024);
                const int to = tl0 + i0 + k - w + 1; old[k] = (to >= 0) ? *(const u32x4*)(base + ((ptrdiff_t)(i0 + k - w + 1)) * 1024) : (u32x4){0u, 0u, 0u, 0u}; }
#pragma unroll
            for (int k = 0; k < 8; ++k) {
                const int tl = tl0 + i0 + k;
                unpack8(cur[k], v);
                const float inv = 1.0f / (float)min(tl + 1, w);
                float o[8], u[8];
#pragma unroll
                for (int e = 0; e < 8; ++e) { S[e] += v[e]; o[e] = S[e] * inv - v[e]; }
                *(u32x4*)(AO + (size_t)(t0 + i0 + k) * 1024 + c * 8) = pack8(o);
                unpack8(old[k], u);
#pragma unroll
                for (int e = 0; e < 8; ++e) S[e] -= u[e];
            }
        }
    }
}

__device__ __forceinline__ void moba_prep_phase(unsigned char* lds, const bf16_t* H, const float* cosT, const float* sinT, const float* qgain, const float* kgain,
                                                bf16_t* Qn, bf16_t* Kimg, bf16_t* VT, float* kmean, int bid, int G, int tid) {
    const int lane = tid & 63, wave = tid >> 6;
    float* red = (float*)lds;
    unsigned char* vts = lds + 8192;
    const int pit0 = (int)(((long)bid * (24 * 64)) / G), pit1 = (int)(((long)(bid + 1) * (24 * 64)) / G);
    float cs[32], sn[32];
    int cur_bn = -1;
    for (int pit = pit0; pit < pit1; ++pit) {
        const int bn = pit / 12, h = pit - bn * 12, b = bn >> 6, n = bn & 63, bh = b * 12 + h;
        const int tk = tid >> 1, half = tid & 1, t = n * 256 + tk;
        const bf16_t* hrow = H + (size_t)(b * SEQ + t) * NMOBA + h * 64 + half * 32;
        if (bn != cur_bn) {
            cur_bn = bn;
#pragma unroll
            for (int i = 0; i < 8; ++i) { const f32x4 a = *(const f32x4*)(cosT + (size_t)t * 32 + 4 * i), bq = *(const f32x4*)(sinT + (size_t)t * 32 + 4 * i);
                cs[4 * i] = a.x; cs[4 * i + 1] = a.y; cs[4 * i + 2] = a.z; cs[4 * i + 3] = a.w; sn[4 * i] = bq.x; sn[4 * i + 1] = bq.y; sn[4 * i + 2] = bq.z; sn[4 * i + 3] = bq.w; }
        }
        u32x4 raw[3][4];
#pragma unroll
        for (int which = 0; which < 3; ++which)
#pragma unroll
            for (int i = 0; i < 4; ++i) raw[which][i] = *(const u32x4*)(hrow + which * 768 + 8 * i);
        float x[32];
#pragma unroll
        for (int which = 0; which < 2; ++which) {
            const float* gn = which ? kgain : qgain;
#pragma unroll
            for (int i = 0; i < 4; ++i) unpack8(raw[which][i], x + 8 * i);
            float sq = 0.f;
#pragma unroll
            for (int i = 0; i < 32; ++i) sq += x[i] * x[i];
            sq += dpp_f<DPP_XOR1>(sq);
            const float rs = rsqrtf(sq * (1.0f / 64.0f) + 1e-6f);
#pragma unroll
            for (int i = 0; i < 32; ++i) { const float xn = x[i] * rs * gn[half * 32 + i]; const float other = dpp_f<DPP_XOR1>(xn); x[i] = half ? (xn * cs[i] + other * sn[i]) : (xn * cs[i] - other * sn[i]); }
            bf16_t* dst = which ? (Kimg + (size_t)(bh * 64 + n) * 16384 + tk * 64 + half * 32) : (Qn + ((size_t)bh * SEQ + t) * 64 + half * 32);
            if (!which) {
#pragma unroll
                for (int i = 0; i < 32; ++i) x[i] *= QSCALE;
            }
#pragma unroll
            for (int i = 0; i < 4; ++i) *(u32x4*)(dst + 8 * i) = pack8(x + 8 * i);
            if (which) {
#pragma unroll
                for (int i = 0; i < 32; ++i) { float s = x[i]; s += dpp_f<DPP_XOR2>(s); s += dpp_f<DPP_ROR4>(s); s += dpp_f<DPP_ROR8>(s); if ((lane & 15) < 2) red[(wave * 4 + (lane >> 4)) * 64 + half * 32 + i] = s; }
            }
        }
        {
#pragma unroll
            for (int i = 0; i < 4; ++i) { const u32x4 w = raw[2][i]; const unsigned ww[4] = {w.x, w.y, w.z, w.w};
#pragma unroll
                for (int e = 0; e < 4; ++e) { *(unsigned short*)(vts + (half * 32 + 8 * i + 2 * e) * 528 + vperm(tk) * 2) = (unsigned short)(ww[e] & 0xffffu); *(unsigned short*)(vts + (half * 32 + 8 * i + 2 * e + 1) * 528 + vperm(tk) * 2) = (unsigned short)(ww[e] >> 16); } }
        }
        __syncthreads();
        if (tid < 64) { float s = 0.f;
#pragma unroll
            for (int w = 0; w < 32; ++w) s += red[w * 64 + tid];
            kmean[(size_t)(bh * 64 + n) * 64 + tid] = s * (1.0f / 256.0f); }
        bf16_t* vdst = VT + (size_t)(bh * 64 + n) * 16384;
#pragma unroll
        for (int i = 0; i < 4; ++i) { const int ch = tid + 512 * i, d = ch >> 5, part = ch & 31; *(u32x4*)(vdst + d * 256 + part * 8) = *(const u32x4*)(vts + d * 528 + part * 16); }
        __syncthreads();
    }
}

__device__ __forceinline__ int list_off(int n) { return 256 * (63 * n - (n * (n - 1)) / 2); }
__device__ __forceinline__ void moba_gate_phase(unsigned char* lds, const bf16_t* Qn, const float* kmean, int* cnt, unsigned short* lists, int bid, int G, int tid) {
    float* km = (float*)lds;
    for (int i0 = bid; i0 < 768; i0 += G) {
        const int rr = i0 >> 8, bb = i0 & 255, c32 = bb & 31;
        const int chunk = rr == 0 ? c32 : (rr == 1 ? 31 - c32 : ((c32 + 16) & 31));
        const int bh = (bb >> 5) + 8 * rr;
        const int nrows = 2 * chunk + 1;
        __syncthreads();
        for (int i = tid; i < nrows * 16; i += 512) ((f32x4*)km)[i] = ((const f32x4*)(kmean + (size_t)bh * 64 * 64))[i];
        __syncthreads();
        const int t = chunk * 512 + tid;
        const int own = __builtin_amdgcn_readfirstlane(t >> 8);
        float q[64];
        const bf16_t* qrow = Qn + ((size_t)bh * SEQ + t) * 64;
#pragma unroll
        for (int i = 0; i < 8; ++i) unpack8(*(const u32x4*)(qrow + 8 * i), q + 8 * i);
        float v0 = -INFINITY, v1 = -INFINITY, v2 = -INFINITY; int i0s = 0, i1s = 0, i2s = 0;
        for (int n = 0; n < own; ++n) {
            const f32x4* kr = (const f32x4*)(km + n * 64);
            float g0 = 0.f, g1 = 0.f, g2 = 0.f, g3 = 0.f;
#pragma unroll
            for (int i = 0; i < 16; ++i) { const f32x4 kv = kr[i]; g0 += q[4 * i] * kv.x; g1 += q[4 * i + 1] * kv.y; g2 += q[4 * i + 2] * kv.z; g3 += q[4 * i + 3] * kv.w; }
            const float g = (g0 + g1) + (g2 + g3);
            if (g > v2) {
                if (g > v1) { v2 = v1; i2s = i1s; if (g > v0) { v1 = v0; i1s = i0s; v0 = g; i0s = n; } else { v1 = g; i1s = n; } }
                else { v2 = g; i2s = n; }
            }
        }
        const int nv = own < 3 ? own : 3;
        unsigned short* lb = lists + (size_t)bh * LIST_PER_BH;
        int* lcnt = (int*)(lds + 16384 + 1024); int* lbase = lcnt + 64;
        if (tid < 64) lcnt[tid] = 0;
        __syncthreads();
        int p0 = 0, p1 = 0, p2 = 0;
        if (nv > 0) p0 = atomicAdd(lcnt + i0s, 1);
        if (nv > 1) p1 = atomicAdd(lcnt + i1s, 1);
        if (nv > 2) p2 = atomicAdd(lcnt + i2s, 1);
        __syncthreads();
        if (tid < 64) { const int c = lcnt[tid]; lbase[tid] = c > 0 ? atomicAdd(cnt + bh * 64 + tid, c) : 0; }
        __syncthreads();
        if (nv > 0) lb[list_off(i0s) + lbase[i0s] + p0] = (unsigned short)((t << 2) | 0);
        if (nv > 1) lb[list_off(i1s) + lbase[i1s] + p1] = (unsigned short)((t << 2) | 1);
        if (nv > 2) lb[list_off(i2s) + lbase[i2s] + p2] = (unsigned short)((t << 2) | 2);
    }
}

struct MobaItem { int bhn, h, n, g, c, nlg; };
__device__ __forceinline__ MobaItem moba_decode(const int* pre, const int* cnt, int bsel, int item) {
    int lo = 0, hi = 768;
    while (hi - lo > 1) { const int mid = (lo + hi) >> 1; if (pre[mid] <= item) lo = mid; else hi = mid; }
    MobaItem it; it.h = lo >> 6; it.n = lo & 63; it.g = item - pre[lo]; it.bhn = (bsel * 12 + it.h) * 64 + it.n; it.c = cnt[it.bhn]; it.nlg = (it.c + 255) >> 8; return it;
}
__device__ __forceinline__ MobaItem moba_fetch(const int* tab, int k) { const int4 v = *(const int4*)(tab + 4 * k); MobaItem it; it.bhn = v.x; it.g = v.y; it.c = v.z; it.nlg = v.w; it.n = v.x & 63; it.h = (v.x >> 6) % 12; return it; }
__device__ __forceinline__ void moba_entry(const MobaItem& it, const unsigned short* lists, int s, int wave, int r, int& t, int& slot, int& klim, bool& valid) {
    const int loc = s * 128 + wave * 16 + r;
    if (it.g < it.nlg) { const int idx = it.g * 256 + loc; valid = idx < it.c; const unsigned e = lists[(size_t)(it.bhn >> 6) * LIST_PER_BH + list_off(it.n) + (valid ? idx : 0)]; t = (int)(e >> 2); slot = (int)(e & 3u); klim = 255; }
    else { klim = loc; t = it.n * 256 + loc; slot = 3; valid = true; }
}
__device__ __forceinline__ void moba_attn_phase(unsigned char* lds, int bsel, const bf16_t* Qn, const bf16_t* Kimg, const bf16_t* VT, const int* cnt, const unsigned short* lists,
                                                bf16_t* Opart, float* lse, const float* qgain, const float* kgain, int vcu, int G, int tid, int mode = 0) {
    const int lane = tid & 63, wave = tid >> 6, r = lane & 15, Gq = lane >> 4;
    const float mc = 64.0f * gain_absmax(qgain, lane) * gain_absmax(kgain, lane) * (0.125f * 1.4426950408889634f);
    int* pre = (int*)(lds + 141312); int* wtot = (int*)(lds + 144392);
    __syncthreads();
    {
        int v0 = 0, v1 = 0;
        if (tid < 384) { const int l0 = 2 * tid, l1 = 2 * tid + 1;
            const int c0 = cnt[(bsel * 12 + (l0 >> 6)) * 64 + (l0 & 63)], c1 = cnt[(bsel * 12 + (l1 >> 6)) * 64 + (l1 & 63)];
            v0 = ((c0 + 255) >> 8) + 1; v1 = ((c1 + 255) >> 8) + 1; }
        const int local = v0 + v1; int incl = local;
#pragma unroll
        for (int o = 1; o < 64; o <<= 1) { const int tt = __shfl_up(incl, o); if (lane >= o) incl += tt; }
        if (lane == 63) wtot[wave] = incl;
        __syncthreads();
        int base = 0;
        for (int w = 0; w < wave; ++w) base += wtot[w];
        const int excl = base + incl - local;
        if (tid < 384) { pre[2 * tid] = excl; pre[2 * tid + 1] = excl + v0; if (tid == 383) pre[768] = excl + local; }
        __syncthreads();
    }
    const int total = pre[768];
    const int it_begin = (int)(((long)vcu * total) / G), it_end = (int)(((long)(vcu + 1) * total) / G);
#define MOBA_ITEM_OF(k) (it_begin + (k))
    int item = MOBA_ITEM_OF(0);
    int* tab = (int*)(lds + 144432);
    if (tid < 64) { const int it = MOBA_ITEM_OF(tid); if (it < it_end) { const MobaItem d = moba_decode(pre, cnt, bsel, it); tab[4 * tid] = d.bhn; tab[4 * tid + 1] = d.g; tab[4 * tid + 2] = d.c; tab[4 * tid + 3] = d.nlg; } }
    __syncthreads();
    if (item >= it_end) return;
    int kidx = 0;
    MobaItem cur = moba_fetch(tab, kidx);
    u32x4 kk[4], vv[4];
    {
        const bf16_t* ks = Kimg + (size_t)cur.bhn * 16384; const bf16_t* vs = VT + (size_t)cur.bhn * 16384;
#pragma unroll
        for (int i = 0; i < 4; ++i) { const int ch = tid + 512 * i; kk[i] = *(const u32x4*)(ks + ch * 8); vv[i] = *(const u32x4*)(vs + ch * 8); }
    }
    int t0, slot0, klim0, t1, slot1, klim1; bool valid0, valid1;
    moba_entry(cur, lists, 0, wave, r, t0, slot0, klim0, valid0);
    moba_entry(cur, lists, 1, wave, r, t1, slot1, klim1, valid1);
    u32x4 q0a, q0b, q1a, q1b;
    { const bf16_t* qr0 = Qn + ((size_t)(cur.bhn >> 6) * SEQ + t0) * 64 + Gq * 8; const bf16_t* qr1 = Qn + ((size_t)(cur.bhn >> 6) * SEQ + t1) * 64 + Gq * 8;
      q0a = *(const u32x4*)(qr0); q0b = *(const u32x4*)(qr0 + 32); q1a = *(const u32x4*)(qr1); q1b = *(const u32x4*)(qr1 + 32); }
    int bufsel = 0; bool fresh = true;
    for (;;) {
        unsigned char* kimg = lds + bufsel * 70656; unsigned char* vt = kimg + 36864;
        if (fresh) {
#pragma unroll
            for (int i = 0; i < 4; ++i) { const int ch = tid + 512 * i; *(u32x4*)(kimg + (ch >> 3) * 144 + (ch & 7) * 16) = kk[i]; *(u32x4*)(vt + (ch >> 5) * 528 + (ch & 31) * 16) = vv[i]; }
            __syncthreads();
        }
        const int nitem = MOBA_ITEM_OF(kidx + 1); const bool has_next = nitem < it_end;
        MobaItem nxt = cur;
        if (has_next) nxt = moba_fetch(tab, kidx + 1);
        const bool nfresh = has_next && nxt.bhn != cur.bhn;
        if (nfresh) {
            const bf16_t* ks = Kimg + (size_t)nxt.bhn * 16384; const bf16_t* vs = VT + (size_t)nxt.bhn * 16384;
#pragma unroll
            for (int i = 0; i < 4; ++i) { const int ch = tid + 512 * i; kk[i] = *(const u32x4*)(ks + ch * 8); vv[i] = *(const u32x4*)(vs + ch * 8); }
        }
        int nt0 = 0, nslot0 = 0, nklim0 = 0, nt1 = 0, nslot1 = 0, nklim1 = 0; bool nvalid0 = false, nvalid1 = false;
        if (has_next) { moba_entry(nxt, lists, 0, wave, r, nt0, nslot0, nklim0, nvalid0); moba_entry(nxt, lists, 1, wave, r, nt1, nslot1, nklim1, nvalid1); }
        const int h = cur.h;
        u32x4 nqa = q0a, nqb = q0b, nqc = q1a, nqd = q1b; bool nq_done = false;
        if (__builtin_amdgcn_readfirstlane(__any((int)valid0))) {
            union { u32x4 u; bf16x8 b; } f0, f1, g0, g1; f0.u = q0a; f1.u = q0b; g0.u = q1a; g1.u = q1b;
            bf16x8 qa[2] = {f0.b, f1.b}, qb[2] = {g0.b, g1.b};
            f32x4 OA[4], OB[4]; float lA, lB;
            attend32(kimg, vt, qa, qb, cur.g >= cur.nlg, klim0, klim1, mc, lane, OA, OB, lA, lB, has_next, Qn + (size_t)(nxt.bhn >> 6) * SEQ * 64 + Gq * 8, nt0, nt1, nqa, nqb, nqc, nqd);
            nq_done = has_next;
            { const bool st = valid0 && mode == 0; const size_t pidx = ((size_t)t0 * 12 + h) * 4 + slot0; store_o_row(OA, 1.0f / lA, Opart + pidx * 64, Gq, st); if (st && Gq == 0) lse[pidx] = mc + __builtin_amdgcn_logf(lA); }
            { const bool st = valid1 && mode == 0; const size_t pidx = ((size_t)t1 * 12 + h) * 4 + slot1; store_o_row(OB, 1.0f / lB, Opart + pidx * 64, Gq, st); if (st && Gq == 0) lse[pidx] = mc + __builtin_amdgcn_logf(lB); }
        }
        if (!has_next) break;
        if (nq_done) { q0a = nqa; q0b = nqb; q1a = nqc; q1b = nqd; }
        else {
            const bf16_t* qr0 = Qn + ((size_t)(nxt.bhn >> 6) * SEQ + nt0) * 64 + Gq * 8; const bf16_t* qr1 = Qn + ((size_t)(nxt.bhn >> 6) * SEQ + nt1) * 64 + Gq * 8;
            q0a = *(const u32x4*)(qr0); q0b = *(const u32x4*)(qr0 + 32); q1a = *(const u32x4*)(qr1); q1b = *(const u32x4*)(qr1 + 32);
        }
        cur = nxt; item = nitem; if (nfresh) bufsel ^= 1; fresh = nfresh; ++kidx;
        t0 = nt0; slot0 = nslot0; klim0 = nklim0; valid0 = nvalid0; t1 = nt1; slot1 = nslot1; klim1 = nklim1; valid1 = nvalid1;
    }
}
#undef MOBA_ITEM_OF
__device__ __forceinline__ void moba_combine_phase(int bsel, const bf16_t* Opart, const float* lse, bf16_t* AO, int gtid, int gthreads) {
    for (int idx = gtid; idx < SEQ * 96; idx += gthreads) {
        const int chunk = idx & 7, th = idx >> 3, h = th % 12, t = th / 12, own = t >> 8, nv = own < 3 ? own : 3;
        const f32x4 ls = *(const f32x4*)(lse + (size_t)th * 4);
        float wv[4] = {nv > 0 ? ls.x : -INFINITY, nv > 1 ? ls.y : -INFINITY, nv > 2 ? ls.z : -INFINITY, ls.w};
        const float mx = fmaxf(fmaxf(wv[0], wv[1]), fmaxf(wv[2], wv[3]));
        float tot = 0.f;
#pragma unroll
        for (int j = 0; j < 4; ++j) { wv[j] = __builtin_amdgcn_exp2f(wv[j] - mx); tot += wv[j]; }
        const float inv = 1.0f / tot;
        float o[8];
#pragma unroll
        for (int e = 0; e < 8; ++e) o[e] = 0.f;
#pragma unroll
        for (int j = 0; j < 4; ++j) { if (j < nv || j == 3) { float v[8]; unpack8(*(const u32x4*)(Opart + ((size_t)th * 4 + j) * 64 + chunk * 8), v); const float wj = wv[j] * inv;
#pragma unroll
            for (int e = 0; e < 8; ++e) o[e] += wj * v[e]; } }
        *(u32x4*)(AO + (size_t)(bsel * SEQ + t) * 1024 + h * 64 + chunk * 8) = pack8(o);
    }
}

__global__ void __launch_bounds__(512, 2) fwd_kernel(Params p) {
    extern __shared__ __attribute__((aligned(16))) unsigned char lds[];
    cg::grid_group grid = cg::this_grid();
    const int tid = threadIdx.x, lane = tid & 63, wave = __builtin_amdgcn_readfirstlane(tid >> 6);
    const int G = gridDim.x, bid = blockIdx.x, gtid = bid * 512 + tid, gthreads = G * 512, gwave = bid * 8 + wave, gwaves = G * 8;
    unsigned char* ws = p.ws;
    bf16_t* WT = (bf16_t*)(ws + OFF_WT); bf16_t* xb = (bf16_t*)(ws + OFF_XB); bf16_t* Qn = (bf16_t*)p.out;     float* ss = (float*)(ws + OFF_SS);
    bf16_t* memb = (bf16_t*)(ws + OFF_MEMB); float* ssm = (float*)(ws + OFF_SSM); bf16_t* memKV = (bf16_t*)(ws + OFF_MEMKV);
    float* cosT = (float*)(ws + OFF_ROPE); float* sinT = cosT + (size_t)SEQ * 32; float* kmean = (float*)(ws + OFF_KMEAN); int* cntAll = (int*)(ws + OFF_CNT);
    bf16_t* H = (bf16_t*)(ws + OFF_H); float* Wtmp = (float*)(ws + OFF_H); bf16_t* AO = (bf16_t*)(ws + OFF_AO); bf16_t* Kimg = (bf16_t*)(ws + OFF_KIMG); bf16_t* VT = (bf16_t*)(ws + OFF_VT);
    unsigned short* lists = (unsigned short*)(ws + OFF_LIST); bf16_t* ACT = (bf16_t*)(ws + OFF_ACT); bf16_t* Opart = (bf16_t*)(ws + OFF_OPART); float* lse = (float*)(ws + OFF_LSE);
    const float* x_in = p.in[0]; const float* mem = p.in[1]; const float* g_mix = p.in[2]; const float* g_mem = p.in[3]; const float* g_mlp = p.in[4];
    const float* w_in_pool = p.in[5]; const float* w_pool_group = p.in[6]; const float* pool_scale = p.in[7]; const float* w_in_moba = p.in[8];
    const float* moba_q_gain = p.in[9]; const float* moba_k_gain = p.in[10]; const float* w_mem_kv = p.in[11]; const float* mem_q_gain = p.in[12]; const float* mem_k_gain = p.in[13];
    const float* w_out = p.in[14]; const float* w_ff1 = p.in[15]; const float* w_ff2 = p.in[16];
    float* xres = p.out;
    const int vcu = (G % 8 == 0) ? (bid % 8) * (G / 8) + bid / 8 : bid;
    const int lo = p.ph_lo, hi = p.ph_hi;
    int ph = 0;
    if (lo < 0) grid.sync();
#define PH_BEGIN if (ph >= lo && ph < hi) {
#define PH_END   if (ph + 1 < hi) xcd_barrier(xbar); } ++ph;
    auto LDSP = (PG8_LAS unsigned char*)lds;
    if (tid < 4) ((unsigned*)(lds + 147456 - 64))[tid] = 0u;
    __syncthreads();
    XcdBarrier xbar = xcd_barrier_post((unsigned*)(ws + OFF_BAR), (volatile LAS unsigned*)(lds + 147456 - 64));

    PH_BEGIN
    {
        float* scr = (float*)lds + wave * (64 * 33);
        int base = 0;
        for (int j = 0; j < 2; ++j) transpose_job(w_in_moba + (size_t)j * D * NMOBA, NMOBA, D, NMOBA, g_mix + (2 * j + 1) * D, WT + wt_in(2 * j + 1), scr, base, gwave, gwaves, lane);
        for (int i = 0; i < 4; ++i) transpose_job(w_mem_kv + (size_t)i * D * 512, 512, D, 512, g_mem + i * D, WT + WT_MEM + (size_t)i * 512 * D, scr, base, gwave, gwaves, lane);
        for (int i = 0; i < 4; ++i) transpose_job(w_out + (size_t)i * D * D, D, D, D, nullptr, WT + WT_OUT + (size_t)i * D * D, scr, base, gwave, gwaves, lane);
        for (int i = 0; i < 4; ++i) transpose_job(w_ff1 + (size_t)i * D * DFF, DFF, D, DFF, g_mlp + i * D, WT + WT_FF1 + (size_t)i * DFF * D, scr, base, gwave, gwaves, lane);
        for (int i = 0; i < 4; ++i) transpose_job(w_ff2 + (size_t)i * DFF * D, D, DFF, D, nullptr, WT + WT_FF2 + (size_t)i * D * DFF, scr, base, gwave, gwaves, lane);
        for (int j = 0; j < 2; ++j) transpose_job(w_in_pool + (size_t)j * D * D + 768, D, D, 256, g_mix + (2 * j) * D, WT + wt_in(2 * j) + (size_t)768 * D, scr, base, gwave, gwaves, lane);
        for (int row = gwave; row < 512; row += gwaves) row_to_bf16(mem + (size_t)row * D, memb + (size_t)row * D, ssm + (size_t)row * 16, lane);
        for (int idx = gtid; idx < SEQ * 32; idx += gthreads) { const int pos = idx >> 5, i = idx & 31; const float inv = powf(10000.0f, -(float)(2 * i) / 64.0f); const float ang = (float)pos * inv; cosT[idx] = cosf(ang); sinT[idx] = sinf(ang); }
        for (int idx = gtid; idx < 4 * 1536; idx += gthreads) cntAll[idx] = 0;
        __syncthreads();
        for (int item = bid; item < 256; item += G) fold_item(lds, w_in_pool, w_pool_group, pool_scale, g_mix, WT, item, tid);
    }
    PH_END
    PH_BEGIN
    {
        if (bid >= 16) { const int gw2 = (bid - 16) * 8 + wave, ngw2 = (G - 16) * 8; int row = gw2; for (; row + ngw2 < M; row += 2 * ngw2) row2_to_bf16(x_in + (size_t)row * D, x_in + (size_t)(row + ngw2) * D, xb + (size_t)row * D, xb + (size_t)(row + ngw2) * D, ss + (size_t)row * 16, ss + (size_t)(row + ngw2) * 16, lane);
            if (row < M) row_to_bf16(x_in + (size_t)row * D, xb + (size_t)row * D, ss + (size_t)row * 16, lane); }
        pg8::Gemm g{memb, WT + WT_MEM, 512, 2048, D}; pg8::StaticOrder S; S.init(512, 2048, G, bid);
        pg8::EpiScale<0> E{memKV, 2048, ssm};
        pg8::gemm_phase<pg8::EpiScale<0>, pg8::StaticOrder, true, true>(LDSP, g, S, E);
    }
    PH_END
#pragma unroll 1
    for (int layer = 0; layer < DEPTH; ++layer) {
        const int j = layer >> 1; const bool moba = layer & 1;
        const int nin = moba ? NMOBA : D;
        PH_BEGIN
        {
            pg8::Gemm g{xb, WT + wt_in(layer), M, nin, D}; pg8::StaticOrder S; S.init(M, nin, G, bid);
            pg8::EpiScale<0> E{H, nin, ss};
            pg8::gemm_phase<pg8::EpiScale<0>, pg8::StaticOrder, true, true>(LDSP, g, S, E);
        }
        PH_END
        if (!moba) {
            PH_BEGIN
            pool_phase(H, AO, launder(gtid), gthreads);
            memattn_phase(lds, H, D, 768, memKV, layer, mem_q_gain + layer * 64, mem_k_gain + layer * 64, AO, bid, G, launder(tid));
            PH_END
        } else {
            int* cnt = cntAll + j * 1536;
            PH_BEGIN
            moba_prep_phase(lds, H, cosT, sinT, moba_q_gain + j * 64, moba_k_gain + j * 64, Qn, Kimg, VT, kmean, bid, G, launder(tid));
            memattn_phase(lds, H, NMOBA, 2304, memKV, layer, mem_q_gain + layer * 64, mem_k_gain + layer * 64, AO, bid, G, launder(tid));
            PH_END
            PH_BEGIN
            moba_gate_phase(lds, Qn, kmean, cnt, lists, bid, G, launder(tid));
            PH_END
#pragma unroll 1
            for (int bsel = 0; bsel < NB; ++bsel) {
                PH_BEGIN
                moba_attn_phase(lds, bsel, Qn, Kimg, VT, cnt, lists, Opart, lse, moba_q_gain + j * 64, moba_k_gain + j * 64, vcu, G, launder(tid));
                PH_END
                PH_BEGIN
                moba_combine_phase(bsel, Opart, lse, AO, launder(gtid), gthreads);
                PH_END
            }
        }
        PH_BEGIN
        {
            __syncthreads();
            pg8::Gemm g{AO, WT + WT_OUT + (size_t)layer * D * D, M, D, D}; pg8::StaticOrder S; S.init(M, D, G, bid);
            pg8::EpiResid E{nullptr, xb, ss};
            pg8::gemm_phase<pg8::EpiResid, pg8::StaticOrder, true, true>(LDSP, g, S, E);
        }
        PH_END
        PH_BEGIN
        {
            pg8::Gemm g{xb, WT + WT_FF1 + (size_t)layer * DFF * D, M, DFF, D}; pg8::StaticOrder S; S.init(M, DFF, G, bid);
            pg8::EpiScale<1> E{ACT, DFF, ss};
            pg8::gemm_phase<pg8::EpiScale<1>, pg8::StaticOrder, true, true>(LDSP, g, S, E);
        }
        PH_END
        PH_BEGIN
        {
            pg8::Gemm g{ACT, WT + WT_FF2 + (size_t)layer * D * DFF, M, D, DFF}; pg8::StaticOrder S; S.init(M, D, G, bid);
            pg8::EpiResid E{layer == DEPTH - 1 ? xres : nullptr, xb, ss};
            pg8::gemm_phase<pg8::EpiResid, pg8::StaticOrder, true, true>(LDSP, g, S, E);
        }
        PH_END
    }
#undef PH_BEGIN
#undef PH_END
}
constexpr int NPHASES = 2 + 2 * 5 + 2 * 10;

extern "C" void kernel_launch(void* const* d_in, const int* in_sizes, int n_in, void* d_out, int out_size, void* d_ws, size_t ws_size, hipStream_t stream) {
    static int grid = 0;
    if (grid == 0) {
        if (n_in != 17 || out_size != M * D || ws_size < WS_END) { fprintf(stderr, "kernel_launch: unexpected shapes (n_in %d out %d ws %zu need %zu)\n", n_in, out_size, ws_size, (size_t)WS_END); grid = -1; return; }
        int dev = 0, cus = 0, per_cu = 0;
        hipGetDevice(&dev); hipDeviceGetAttribute(&cus, hipDeviceAttributeMultiprocessorCount, dev);
        hipFuncSetAttribute((const void*)fwd_kernel, hipFuncAttributeMaxDynamicSharedMemorySize, LDS_BYTES);
        hipOccupancyMaxActiveBlocksPerMultiprocessor(&per_cu, (const void*)fwd_kernel, 512, LDS_BYTES);
        (void)hipGetLastError();
        if (per_cu < 1) per_cu = 1;
        grid = cus * per_cu;
    }
    if (grid < 0) return;
    if (hipMemsetAsync((char*)d_ws + OFF_BAR, 0, 16384, stream) != hipSuccess) { fprintf(stderr, "memset failed\n"); return; }
    Params p{};
    for (int i = 0; i < 17; ++i) p.in[i] = (const float*)d_in[i];
    p.out = (float*)d_out; p.ws = (unsigned char*)d_ws;
#if MK_SINGLE
    p.ph_lo = 0; p.ph_hi = NPHASES;
    { void* args[] = {&p}; hipError_t e = hipLaunchCooperativeKernel((const void*)fwd_kernel, dim3(grid), dim3(512), args, LDS_BYTES, stream);
      if (e != hipSuccess) fprintf(stderr, "cooperative launch failed: %s (grid %d)\n", hipGetErrorString(e), grid); }
#else
    for (int ph = 0; ph < NPHASES; ++ph) {
        p.ph_lo = ph; p.ph_hi = ph + 1; void* args[] = {&p};
        hipError_t e = hipLaunchCooperativeKernel((const void*)fwd_kernel, dim3(grid), dim3(512), args, LDS_BYTES, stream);
        if (e != hipSuccess) { fprintf(stderr, "launch %d failed: %s (grid %d)\n", ph, hipGetErrorString(e), grid); break; }
    }
#endif
}
```
